# Optimizing an MI355X kernel written in HIP

```python
import math
import jax, jax.numpy as jnp
from jax import lax
import numpy as np

D_MODEL = 1024
BATCH = 2
SEQ = 8192
DEPTH = 4
DEC_BATCH = 128
DEC_SEQ = 8
PAST_LEN = 8192
PAGE_SIZE = 128

N_A_LAYERS = DEPTH // 2
N_B_LAYERS = DEPTH - N_A_LAYERS
CHUNK = 128
D_SGU = 2 * D_MODEL
SGU_GROUPS = 8
SGU_GROUP_DIM = D_SGU // SGU_GROUPS
HEAD_DIM = 64
N_HEADS = D_MODEL // HEAD_DIM
N_KV_HEADS = max(1, N_HEADS // 8)
GROUP = N_HEADS // N_KV_HEADS
WINDOW = 128
PEER_HEADS = 8
N_KEYS = 128
N_EXPERTS = N_KEYS * N_KEYS
D_KEY = 256
PEER_TOPK = 16
PEER_BLOCK = 256
D_PLE = 256
DEEPNORM_ALPHA = (2.0 * DEPTH) ** 0.25
DEEPNORM_BETA = (8.0 * DEPTH) ** -0.25
LN_EPS = 1e-5

kernel_name = "yoco_sgu_swa_sink_peer_decoder_step"


def layer_norm(x, g, b):
    xf = x.astype(jnp.float32)
    mu = jnp.mean(xf, -1, keepdims=True)
    var = jnp.mean(jnp.square(xf - mu), -1, keepdims=True)
    y = (xf - mu) * lax.rsqrt(var + LN_EPS)
    return (y * g.astype(jnp.float32) + b.astype(jnp.float32)).astype(x.dtype)


def alibi_slopes():
    s = [2.0 ** (-8.0 * (h + 1) / N_HEADS) for h in range(N_HEADS)]
    return jnp.asarray(s, jnp.float32).reshape(N_KV_HEADS, GROUP)


def sgu_mixer(x, w_in, b_in, ln_g, ln_b, w_s, b_s, w_out, b_out):
    bsz, L, _ = x.shape
    z = jax.nn.gelu(x @ w_in + b_in)
    u, v = jnp.split(z, 2, axis=-1)
    v = layer_norm(v, ln_g, ln_b)
    c = min(L, CHUNK)
    n = L // c
    mask = jnp.tril(jnp.ones((c, c), bool))
    ws = jnp.where(mask, w_s[:, :c, :c], 0.0)
    vc = v.reshape(bsz, n, c, SGU_GROUPS, SGU_GROUP_DIM)
    mixed = jnp.einsum('gts,bnsgc->bntgc', ws, vc) + b_s[:, :c].T[None, None, :, :, None]
    gated = u * mixed.reshape(bsz, L, D_SGU)
    return gated @ w_out + b_out, v


def shared_kv(h, w_kv):
    bsz, L, _ = h.shape
    kv = (h @ w_kv).reshape(bsz, L, 2, N_KV_HEADS, HEAD_DIM)
    return kv[:, :, 0], kv[:, :, 1]


def sink_softmax(s, mask, sinks):
    s = jnp.where(mask, s, -jnp.inf)
    sink = sinks.astype(jnp.float32)[:, :, None, None]
    m = jnp.maximum(jnp.max(s, -1, keepdims=True), sink)
    p = jnp.exp(s - m)
    return p / (jnp.sum(p, -1, keepdims=True) + jnp.exp(sink - m))


def window_attn_prompt(x, k, v, w_q, sinks, w_o, slopes):
    bsz, S, _ = x.shape
    nb = S // WINDOW
    q = (x @ w_q).reshape(bsz, nb, WINDOW, N_KV_HEADS, GROUP, HEAD_DIM)
    kb = k.reshape(bsz, nb, WINDOW, N_KV_HEADS, HEAD_DIM)
    vb = v.reshape(bsz, nb, WINDOW, N_KV_HEADS, HEAD_DIM)
    pad = ((0, 0), (1, 0), (0, 0), (0, 0), (0, 0))
    kk = jnp.concatenate([jnp.pad(kb, pad)[:, :-1], kb], axis=2)
    vv = jnp.concatenate([jnp.pad(vb, pad)[:, :-1], vb], axis=2)
    s = jnp.einsum('bnqkgd,bnskd->bnkgqs', q, kk).astype(jnp.float32) * (HEAD_DIM ** -0.5)
    qi = jnp.arange(WINDOW)[:, None] + WINDOW
    kj = jnp.arange(2 * WINDOW)[None, :]
    dist = qi - kj
    blk = jnp.arange(nb)[:, None, None]
    valid = (dist >= 0) & (dist < WINDOW) & ((blk > 0) | (kj >= WINDOW))
    s = s - slopes[:, :, None, None] * dist.astype(jnp.float32)
    p = sink_softmax(s, valid[None, :, None, None], sinks)
    o = jnp.einsum('bnkgqs,bnskd->bnqkgd', p.astype(vv.dtype), vv)
    return o.reshape(bsz, S, N_HEADS * HEAD_DIM) @ w_o


def window_attn_sample(x, k_all, v_all, w_q, sinks, w_o, slopes):
    bsz, L, _ = x.shape
    wc = k_all.shape[1] - L
    q = (x @ w_q).reshape(bsz, L, N_KV_HEADS, GROUP, HEAD_DIM)
    s = jnp.einsum('bqkgd,bskd->bkgqs', q, k_all).astype(jnp.float32) * (HEAD_DIM ** -0.5)
    dist = (jnp.arange(L)[:, None] + wc) - jnp.arange(wc + L)[None, :]
    valid = (dist >= 0) & (dist < WINDOW)
    s = s - slopes[:, :, None, None] * dist.astype(jnp.float32)
    p = sink_softmax(s, valid, sinks)
    o = jnp.einsum('bkgqs,bskd->bqkgd', p.astype(v_all.dtype), v_all)
    return o.reshape(bsz, L, N_HEADS * HEAD_DIM) @ w_o


def peer(x, w_q, subkeys, u_tab, v_tab):
    shp = x.shape
    xt = x.reshape(-1, D_MODEL)
    T = xt.shape[0]
    blk = min(PEER_BLOCK, T)
    Tp = -(-T // blk) * blk
    xb = jnp.pad(xt, ((0, Tp - T), (0, 0))).reshape(Tp // blk, blk, D_MODEL)

    def one_block(xs):
        q = (xs @ w_q).reshape(blk, PEER_HEADS, 2, D_KEY // 2)
        s = jnp.einsum('thpc,pnc->thpn', q, subkeys).astype(jnp.float32)
        s1, i1 = lax.top_k(s[:, :, 0], PEER_TOPK)
        s2, i2 = lax.top_k(s[:, :, 1], PEER_TOPK)
        cand = (s1[..., :, None] + s2[..., None, :]).reshape(blk, PEER_HEADS, PEER_TOPK * PEER_TOPK)
        cidx = (i1[..., :, None] * N_KEYS + i2[..., None, :]).reshape(blk, PEER_HEADS, PEER_TOPK * PEER_TOPK)
        top_s, pos = lax.top_k(cand, PEER_TOPK)
        eidx = jnp.take_along_axis(cidx, pos, -1).reshape(blk, PEER_HEADS * PEER_TOPK)
        g = jax.nn.softmax(top_s, -1).reshape(blk, PEER_HEADS * PEER_TOPK)
        act = jax.nn.gelu(jnp.einsum('ted,td->te', u_tab[eidx], xs))
        return jnp.einsum('te,ted->td', g.astype(act.dtype) * act, v_tab[eidx])

    y = lax.map(one_block, xb)
    return y.reshape(Tp, D_MODEL)[:T].reshape(shp)


def setup_inputs(seed: int = 0) -> dict:
    key = jax.random.key(seed)
    ks = iter(jax.random.split(key, 48))

    def nrm(shape, scale):
        return jax.random.normal(next(ks), shape, jnp.float32) * scale

    wc = min(WINDOW, PAST_LEN)
    kvd = N_KV_HEADS * HEAD_DIM
    return {
        "x_prompt": nrm((BATCH, SEQ, D_MODEL), 1.0),
        "x_sample": nrm((DEC_BATCH, DEC_SEQ, D_MODEL), 1.0),
        "cache_k_win": nrm((DEC_BATCH, wc, N_KV_HEADS, HEAD_DIM), 1.0),
        "cache_v_win": nrm((DEC_BATCH, wc, N_KV_HEADS, HEAD_DIM), 1.0),
        "p_prompt": nrm((DEPTH, BATCH, SEQ, D_PLE), 1.0),
        "p_sample": nrm((DEPTH, DEC_BATCH, DEC_SEQ, D_PLE), 1.0),
        "ln1_g": 1.0 + nrm((DEPTH, D_MODEL), 0.02),
        "ln1_b": nrm((DEPTH, D_MODEL), 0.02),
        "ln2_g": 1.0 + nrm((DEPTH, D_MODEL), 0.02),
        "ln2_b": nrm((DEPTH, D_MODEL), 0.02),
        "sgu_w_in": nrm((N_A_LAYERS, D_MODEL, 2 * D_SGU), D_MODEL ** -0.5),
        "sgu_b_in": nrm((N_A_LAYERS, 2 * D_SGU), 0.02),
        "sgu_ln_g": 1.0 + nrm((N_A_LAYERS, D_SGU), 0.02),
        "sgu_ln_b": nrm((N_A_LAYERS, D_SGU), 0.02),
        "sgu_w_s": nrm((N_A_LAYERS, SGU_GROUPS, CHUNK, CHUNK), 0.5 * CHUNK ** -0.5),
        "sgu_b_s": 1.0 + nrm((N_A_LAYERS, SGU_GROUPS, CHUNK), 0.02),
        "sgu_w_out": nrm((N_A_LAYERS, D_SGU, D_MODEL), DEEPNORM_BETA * D_SGU ** -0.5),
        "sgu_b_out": nrm((N_A_LAYERS, D_MODEL), 0.02),
        "attn_w_kv": nrm((D_MODEL, 2 * kvd), D_MODEL ** -0.5),
        "attn_w_q": nrm((N_B_LAYERS, D_MODEL, N_HEADS * HEAD_DIM), D_MODEL ** -0.5),
        "attn_sinks": nrm((N_B_LAYERS, N_HEADS), 0.5),
        "attn_w_o": nrm((N_B_LAYERS, N_HEADS * HEAD_DIM, D_MODEL), DEEPNORM_BETA * (N_HEADS * HEAD_DIM) ** -0.5),
        "peer_w_q": nrm((DEPTH, D_MODEL, PEER_HEADS * D_KEY), D_MODEL ** -0.5),
        "peer_subkeys": nrm((DEPTH, 2, N_KEYS, D_KEY // 2), (D_KEY // 2) ** -0.5),
        "peer_u": nrm((DEPTH, N_EXPERTS, D_MODEL), D_MODEL ** -0.5),
        "peer_v": nrm((DEPTH, N_EXPERTS, D_MODEL), DEEPNORM_BETA * PEER_HEADS ** -0.5),
        "ple_w": nrm((DEPTH, D_PLE, D_MODEL), D_PLE ** -0.5),
        "ple_gate_w": nrm((DEPTH, D_MODEL, D_MODEL), D_MODEL ** -0.5),
        "ple_gate_b": nrm((DEPTH, D_MODEL), 0.02),
    }


def reference(x_prompt, x_sample, cache_k_win, cache_v_win, p_prompt, p_sample,
              ln1_g, ln1_b, ln2_g, ln2_b,
              sgu_w_in, sgu_b_in, sgu_ln_g, sgu_ln_b, sgu_w_s, sgu_b_s, sgu_w_out, sgu_b_out,
              attn_w_kv, attn_w_q, attn_sinks, attn_w_o,
              peer_w_q, peer_subkeys, peer_u, peer_v,
              ple_w, ple_gate_w, ple_gate_b):
    slopes = alibi_slopes()

    def channel_and_ple(h, p, i):
        h = layer_norm(DEEPNORM_ALPHA * h + peer(h, peer_w_q[i], peer_subkeys[i], peer_u[i], peer_v[i]),
                       ln2_g[i], ln2_b[i])
        gate = jax.nn.sigmoid(h @ ple_gate_w[i] + ple_gate_b[i])
        return h + gate * (p @ ple_w[i])

    hp, hs = x_prompt, x_sample
    sgu_rows = []
    kp = vp = k_all = v_all = None
    for i in range(DEPTH):
        if i < N_A_LAYERS:
            a_args = (sgu_w_in[i], sgu_b_in[i], sgu_ln_g[i], sgu_ln_b[i],
                      sgu_w_s[i], sgu_b_s[i], sgu_w_out[i], sgu_b_out[i])
            mp, _ = sgu_mixer(hp, *a_args)
            ms, v_rows = sgu_mixer(hs, *a_args)
            sgu_rows.append(v_rows)
        else:
            if i == N_A_LAYERS:
                kp, vp = shared_kv(hp, attn_w_kv)
                kn, vn = shared_kv(hs, attn_w_kv)
                k_all = jnp.concatenate([cache_k_win.astype(kn.dtype), kn], axis=1)
                v_all = jnp.concatenate([cache_v_win.astype(vn.dtype), vn], axis=1)
            j = i - N_A_LAYERS
            sinks = attn_sinks[j].reshape(N_KV_HEADS, GROUP)
            mp = window_attn_prompt(hp, kp, vp, attn_w_q[j], sinks, attn_w_o[j], slopes)
            ms = window_attn_sample(hs, k_all, v_all, attn_w_q[j], sinks, attn_w_o[j], slopes)
        hp = layer_norm(DEEPNORM_ALPHA * hp + mp, ln1_g[i], ln1_b[i])
        hs = layer_norm(DEEPNORM_ALPHA * hs + ms, ln1_g[i], ln1_b[i])
        hp = channel_and_ple(hp, p_prompt[i], i)
        hs = channel_and_ple(hs, p_sample[i], i)

    wc = cache_k_win.shape[1]
    new_k_win_prompt = kp[:, -WINDOW:]
    new_v_win_prompt = vp[:, -WINDOW:]
    new_k_win_sample = k_all[:, -wc:]
    new_v_win_sample = v_all[:, -wc:]
    new_sgu_v_sample = jnp.stack(sgu_rows, axis=0)
    return (hp, hs, new_k_win_prompt, new_v_win_prompt, new_k_win_sample, new_v_win_sample, new_sgu_v_sample)
```

```cpp
#include <hip/hip_runtime.h>
#include <cstdio>
#include <cstdint>
namespace pg8 {
#define PG8_LAS __attribute__((address_space(3)))
typedef unsigned short bf16_t;
typedef short bf16x8 __attribute__((ext_vector_type(8)));
typedef float f32x4 __attribute__((ext_vector_type(4)));
typedef unsigned u32x4 __attribute__((ext_vector_type(4)));
constexpr int BM = 256, BK = 64, HALF = 128, HTB = HALF * BK * 2  , STAGE_BYTES = 8 * HTB, NXCD = 8, WGM = 8;

__host__ __device__ __forceinline__ int lds_byte(int r, int c) { const int st = (r >> 4) * 2 + (c >> 5), rr = r & 15, cc = c & 31, ob = rr * 64 + cc * 2; return st * 1024 + (ob ^ (((ob >> 9) & 1) << 5)); }
__host__ __device__ __forceinline__ void stage_rc(int b, int& R, int& C) { const int st = b / 1024, sb = b % 1024, swz = sb ^ (((sb >> 9) & 1) << 5); R = (st >> 1) * 16 + swz / 64; C = (st & 1) * 32 + (swz % 64) / 2; }
__host__ __device__ __forceinline__ int perm32(int rho) { const int n = rho >> 4, i = rho & 15; return 8 * (i >> 2) + 4 * n + (i & 3); }

struct Unit { int pm, pn, pb; };
struct Gemm { const bf16_t* A; const bf16_t* Bt; int M, N, K; };

struct StaticOrder {
    int nM, nN, nwg, G, c, mper;
    __host__ __device__ void init(int M, int N, int G_, int c_, int mper_ = 1 << 28) { nM = M / BM; nN = N / BM; nwg = nM * nN; G = G_; c = c_; mper = mper_; }
    __host__ __device__ bool next(int i, Unit& u) const {
        const long L = (long)i * G + c; if (L >= nwg) return false;
        int wgid = (int)L; { const int q = nwg / NXCD, r = nwg % NXCD, xcd = wgid % NXCD, off = wgid / NXCD; wgid = (xcd < r ? xcd * (q + 1) : r * (q + 1) + (xcd - r) * q) + off; }
        const int nig = WGM * nN, gid = wgid / nig, fm = gid * WGM, gsz = (nM - fm) < WGM ? (nM - fm) : WGM;
        u.pm = fm + ((wgid % nig) % gsz); u.pn = (wgid % nig) / gsz; u.pb = ((u.pm >= mper) + (u.pm >= 2 * mper) + (u.pm >= 3 * mper)) * nN + u.pn; return true;
    }
    __device__ __forceinline__ void a_ready(const Unit&) const {}
    __device__ __forceinline__ void done(const Unit&) const {}
};
__device__ __forceinline__ unsigned cvt_pk_bf16(float lo, float hi) { unsigned r; asm volatile("v_cvt_pk_bf16_f32 %0, %1, %2" : "=v"(r) : "v"(lo), "v"(hi)); return r; }
typedef float f32x2 __attribute__((ext_vector_type(2)));
template <class Epi, class Sched, bool ALIGN_EPI = false, bool SP2 = false>
__device__ __forceinline__ void gemm_phase(PG8_LAS unsigned char* lds, const Gemm g, const Sched& S, const Epi& E, int tid_in) {
    int tid_ = tid_in; asm volatile("" : "+v"(tid_));
    const int tid = tid_, wid = __builtin_amdgcn_readfirstlane(tid >> 6), lane = tid & 63, wr = wid >> 2, wc = wid & 3, fr = lane & 15, fq = lane >> 4;
    const int K = g.K, nt = K / BK;
    unsigned voffA[2], voffB[2];
#pragma unroll
    for (int i = 0; i < 2; ++i) { int R, C; stage_rc(tid * 16 + i * 8192, R, C); const int Rb = Epi::PERM ? ((R & ~31) + perm32(R & 31)) : R;
        voffA[i] = (unsigned)(R * K + C) * 2u; voffB[i] = (unsigned)(Rb * K + C) * 2u; }
    const size_t kstep = (size_t)(BK * 2);
    const size_t hstep = (size_t)HALF * K * 2;
    const size_t tstep = 2 * hstep;
    const unsigned ldsw = (unsigned)wid * 1024u;
    const int aoff = lds_byte(wr * 64 + fr, fq * 8), boff = lds_byte(wc * 32 + fr, fq * 8);
#define PG8_SA(b, h) (((b) * 2 + (h)) * HTB)
#define PG8_SB(b, h) ((4 + (b) * 2 + (h)) * HTB)
#define PG8_STAGE(bufoff, gbase, voff) do { _Pragma("unroll") for (int _i = 0; _i < 2; ++_i) \
        __builtin_amdgcn_global_load_lds((const unsigned*)((const char*)(gbase) + (voff)[_i]), (PG8_LAS unsigned*)(lds + (bufoff) + ldsw + _i * 8192), 16, 0, 0); } while (0)
#define PG8_LDA(dst, b, h) do { _Pragma("unroll") for (int m = 0; m < 4; ++m) _Pragma("unroll") for (int k = 0; k < 2; ++k) dst[m][k] = *(const PG8_LAS bf16x8*)(lds + PG8_SA(b, h) + aoff + m * 2048 + k * 1024); } while (0)
#define PG8_LDB(dst, b, h) do { _Pragma("unroll") for (int n = 0; n < 2; ++n) _Pragma("unroll") for (int k = 0; k < 2; ++k) dst[n][k] = *(const PG8_LAS bf16x8*)(lds + PG8_SB(b, h) + boff + n * 2048 + k * 1024); } while (0)
#define PG8_MMA(ai, bj, At, Bt) do { __builtin_amdgcn_s_setprio(1); _Pragma("unroll") for (int m = 0; m < 4; ++m) _Pragma("unroll") for (int n = 0; n < 2; ++n) _Pragma("unroll") for (int k = 0; k < 2; ++k) \
        acc[ai][bj][m][n] = __builtin_amdgcn_mfma_f32_16x16x32_bf16(Bt[n][k], At[m][k], acc[ai][bj][m][n], 0, 0, 0); __builtin_amdgcn_s_setprio(0); } while (0)
#define PG8_WAIT_V(n) asm volatile("s_waitcnt vmcnt(" #n ")" ::: "memory")
#define PG8_WAIT_L(n) asm volatile("s_waitcnt lgkmcnt(" #n ")" ::: "memory")
#define PG8_BAR __builtin_amdgcn_s_barrier()
#define PG8_SCHED __builtin_amdgcn_sched_barrier(0)
    Unit cur, nxt; int ui = 0;
    if (!S.next(0, cur)) return;
    f32x4 acc[2][2][4][2];
#pragma unroll
    for (int a = 0; a < 2; ++a)
#pragma unroll
        for (int b = 0; b < 2; ++b)
#pragma unroll
            for (int m = 0; m < 4; ++m)
#pragma unroll
                for (int n = 0; n < 2; ++n) acc[a][b][m][n] = (f32x4){0.f, 0.f, 0.f, 0.f};
    bf16x8 At[4][2], B0[2][2], B1[2][2];
    const char* cA = (const char*)g.A + (size_t)cur.pm * tstep; const char* cB = (const char*)g.Bt + (size_t)cur.pb * tstep;
    S.a_ready(cur);
    if constexpr (SP2) {
        PG8_STAGE(PG8_SB(0, 0), cB, voffB); PG8_STAGE(PG8_SB(0, 1), cB + hstep, voffB); PG8_STAGE(PG8_SA(0, 0), cA, voffA); PG8_STAGE(PG8_SA(0, 1), cA + hstep, voffA);
        if (wr == 1) PG8_BAR;
        PG8_WAIT_V(2); PG8_BAR;
        PG8_STAGE(PG8_SB(1, 0), cB + kstep, voffB); PG8_STAGE(PG8_SA(1, 0), cA + kstep, voffA); PG8_STAGE(PG8_SB(1, 1), cB + hstep + kstep, voffB);
        PG8_WAIT_V(6); PG8_BAR;
    } else {
        PG8_STAGE(PG8_SB(0, 0), cB, voffB); PG8_STAGE(PG8_SA(0, 0), cA, voffA); PG8_STAGE(PG8_SB(0, 1), cB + hstep, voffB); PG8_STAGE(PG8_SA(0, 1), cA + hstep, voffA);
        if (wr == 1) PG8_BAR;
        PG8_WAIT_V(4); PG8_BAR;
        PG8_STAGE(PG8_SB(1, 0), cB + kstep, voffB); PG8_STAGE(PG8_SA(1, 0), cA + kstep, voffA); PG8_STAGE(PG8_SB(1, 1), cB + hstep + kstep, voffB);
        PG8_WAIT_V(6); PG8_BAR;
    }
    for (;;) {
        const bool has_next = S.next(ui + 1, nxt);
        const char* nA = has_next ? (const char*)g.A + (size_t)nxt.pm * tstep : cA; const char* nB = has_next ? (const char*)g.Bt + (size_t)nxt.pb * tstep : cB;
        for (int t = 0; t < nt; t += 2) {
            const bool last = (t == nt - 2);
            const char* a1 = cA + (size_t)(t + 1) * kstep;
            const char* a2 = last ? nA : cA + (size_t)(t + 2) * kstep; const char* b2 = last ? nB : cB + (size_t)(t + 2) * kstep;
            const char* a3 = a2 + kstep; const char* b3 = b2 + kstep;
            if (last && has_next) S.a_ready(nxt);
            if constexpr (SP2) {
            PG8_LDB(B0, 0, 0); PG8_LDB(B1, 0, 1); PG8_SCHED; PG8_LDA(At, 0, 0); PG8_STAGE(PG8_SA(1, 1), a1 + hstep, voffA);
            PG8_WAIT_V(8); PG8_WAIT_L(0); PG8_BAR; PG8_MMA(0, 0, At, B0); PG8_MMA(0, 1, At, B1); PG8_BAR; PG8_SCHED;
            PG8_LDA(At, 0, 1); PG8_STAGE(PG8_SB(0, 0), b2, voffB); PG8_STAGE(PG8_SB(0, 1), b2 + hstep, voffB); PG8_STAGE(PG8_SA(0, 0), a2, voffA);
            PG8_WAIT_V(8); PG8_WAIT_L(0); PG8_BAR; PG8_MMA(1, 0, At, B0); PG8_MMA(1, 1, At, B1); PG8_BAR; PG8_SCHED;
            PG8_LDB(B0, 1, 0); PG8_LDB(B1, 1, 1); PG8_SCHED; PG8_LDA(At, 1, 0); PG8_STAGE(PG8_SA(0, 1), a2 + hstep, voffA);
            PG8_WAIT_V(8); PG8_WAIT_L(0); PG8_BAR; PG8_MMA(0, 0, At, B0); PG8_MMA(0, 1, At, B1); PG8_BAR; PG8_SCHED;
            PG8_LDA(At, 1, 1); PG8_STAGE(PG8_SB(1, 0), b3, voffB); PG8_STAGE(PG8_SB(1, 1), b3 + hstep, voffB); PG8_STAGE(PG8_SA(1, 0), a3, voffA);
            PG8_WAIT_V(8); PG8_WAIT_L(0); PG8_BAR; PG8_MMA(1, 0, At, B0); PG8_MMA(1, 1, At, B1); PG8_BAR; PG8_SCHED;
            } else {
            PG8_LDB(B0, 0, 0); PG8_SCHED; PG8_LDA(At, 0, 0); PG8_STAGE(PG8_SA(1, 1), a1 + hstep, voffA);
            PG8_WAIT_L(8); PG8_BAR; PG8_WAIT_L(0); PG8_MMA(0, 0, At, B0); PG8_BAR; PG8_SCHED;
            PG8_LDB(B1, 0, 1); PG8_STAGE(PG8_SB(0, 0), b2, voffB);
            PG8_BAR; PG8_WAIT_L(0); PG8_MMA(0, 1, At, B1); PG8_BAR;
            PG8_LDA(At, 0, 1); PG8_STAGE(PG8_SA(0, 0), a2, voffA);
            PG8_BAR; PG8_WAIT_L(0); PG8_MMA(1, 0, At, B0); PG8_BAR; PG8_SCHED;
            PG8_STAGE(PG8_SB(0, 1), b2 + hstep, voffB);
            PG8_WAIT_V(6); PG8_BAR; PG8_MMA(1, 1, At, B1); PG8_BAR;
            PG8_LDB(B0, 1, 0); PG8_SCHED; PG8_LDA(At, 1, 0); PG8_STAGE(PG8_SA(0, 1), a2 + hstep, voffA);
            PG8_WAIT_L(8); PG8_BAR; PG8_WAIT_L(0); PG8_MMA(0, 0, At, B0); PG8_BAR; PG8_SCHED;
            PG8_LDB(B1, 1, 1); PG8_STAGE(PG8_SB(1, 0), b3, voffB);
            PG8_BAR; PG8_WAIT_L(0); PG8_MMA(0, 1, At, B1); PG8_BAR;
            PG8_LDA(At, 1, 1); PG8_STAGE(PG8_SA(1, 0), a3, voffA);
            PG8_BAR; PG8_WAIT_L(0); PG8_MMA(1, 0, At, B0); PG8_BAR; PG8_SCHED;
            PG8_STAGE(PG8_SB(1, 1), b3 + hstep, voffB);
            PG8_WAIT_V(6); PG8_BAR; PG8_MMA(1, 1, At, B1); PG8_BAR;
            }
        }
        if constexpr (ALIGN_EPI) { if (wr == 0) PG8_BAR; }
        if constexpr (!Epi::AFTER_DRAIN) { E(acc, cur, wr, wc, fr, fq); S.done(cur); }
        if (!has_next) break;
#pragma unroll
        for (int a = 0; a < 2; ++a)
#pragma unroll
            for (int b = 0; b < 2; ++b)
#pragma unroll
                for (int m = 0; m < 4; ++m)
#pragma unroll
                    for (int n = 0; n < 2; ++n) acc[a][b][m][n] = (f32x4){0.f, 0.f, 0.f, 0.f};
        cur = nxt; cA = nA; cB = nB; ++ui;
        if constexpr (ALIGN_EPI) { if (wr == 1) PG8_BAR; }
    }
    PG8_WAIT_V(0);
    if constexpr (!ALIGN_EPI) { if (wr == 0) PG8_BAR; }
    PG8_BAR;
    if constexpr (Epi::AFTER_DRAIN) { E.fused(acc, cur, wr, wc, fr, fq, lds, wid, lane); S.done(cur); }
#undef PG8_SA
#undef PG8_SB
#undef PG8_STAGE
#undef PG8_LDA
#undef PG8_LDB
#undef PG8_MMA
#undef PG8_WAIT_V
#undef PG8_WAIT_L
#undef PG8_BAR
#undef PG8_SCHED
}
}

#ifndef MK_N_LAUNCHES
#define MK_N_LAUNCHES 1
#endif
constexpr int NWAVES = 8;
constexpr int TP = 16384, TS = 1024, T = TP + TS;
constexpr int D = 1024, DSGU = 2048, NEXP = 16384, DPLE = 256;
constexpr int NPHASE = 34;
constexpr float ALPHA = 1.681792830507429f;
constexpr float LN_EPS = 1e-5f;
constexpr size_t O_YP = 0, O_YS = 16777216, O_KP = 17825792, O_VP = 17858560, O_KS = 17891328, O_VS = 19988480, O_SGU = 22085632, O_END = 26279936;

constexpr size_t MiB = 1u << 20;
constexpr size_t WS_CTL = 0, CTL_ZERO_BYTES = 65536;
constexpr size_t WS_STATS = 925 * MiB;
constexpr size_t WS_WIN = 2 * MiB;
constexpr size_t WS_WOUT = 18 * MiB;
constexpr size_t WS_WQKV = 26 * MiB;
constexpr size_t WS_WQ1 = 29 * MiB;
constexpr size_t WS_WO = 31 * MiB;
constexpr size_t WS_WQK = 35 * MiB;
constexpr size_t WS_PLE = 51 * MiB;
constexpr size_t WS_GATE = 53 * MiB;
constexpr size_t WS_WSB = 61 * MiB;
constexpr size_t WS_PU = 64 * MiB;
constexpr size_t WS_PV = 192 * MiB;
constexpr size_t WS_PBF = 320 * MiB;
constexpr size_t WS_PP = 354 * MiB;
constexpr size_t WS_HF = 490 * MiB;
constexpr size_t WS_HB = 558 * MiB;
constexpr size_t WS_PRE = 592 * MiB;
constexpr size_t WS_Z = 660 * MiB;
constexpr size_t WS_SC = 660 * MiB;
constexpr size_t WS_GATED = 796 * MiB;
constexpr size_t WS_QB = 796 * MiB;
constexpr size_t WS_ATT = 830 * MiB;
constexpr size_t WS_EIDX = 864 * MiB;
constexpr size_t WS_GW = 873 * MiB;
constexpr size_t WS_KVB = 882 * MiB;
constexpr size_t WS_HB2 = 891 * MiB;
constexpr size_t WS_END = 930 * MiB;
constexpr int CW_BAR = 4096;

constexpr int RING_BYTES = 131072;
constexpr int LDSCTL_OFF = RING_BYTES, MISC_OFF = LDSCTL_OFF + 320;
constexpr int LDS_BYTES = 147456;

#define GAS __attribute__((address_space(1)))
#define LAS __attribute__((address_space(3)))
typedef unsigned short bf16;
typedef unsigned v4u __attribute__((ext_vector_type(4)));
typedef unsigned v2u __attribute__((ext_vector_type(2)));
typedef float f32x4 __attribute__((ext_vector_type(4)));
typedef float f32x2 __attribute__((ext_vector_type(2)));
typedef float f32x16 __attribute__((ext_vector_type(16)));
typedef short bf16x8 __attribute__((ext_vector_type(8)));
typedef short s16x4 __attribute__((ext_vector_type(4)));
typedef __bf16 bf16x2v __attribute__((ext_vector_type(2)));
typedef GAS unsigned gu32;
#define RLX_AGENT __ATOMIC_RELAXED, __HIP_MEMORY_SCOPE_AGENT
#define LDS_WAIT() asm volatile("s_waitcnt lgkmcnt(0)" ::: "memory")
#define VM_WAIT() asm volatile("s_waitcnt vmcnt(0)" ::: "memory")
__device__ __forceinline__ unsigned f2bf(float f) { unsigned u = __builtin_bit_cast(unsigned, f); return (u + 0x7fffu + ((u >> 16) & 1u)) >> 16; }
typedef __bf16 bf2v __attribute__((ext_vector_type(2)));
__device__ __forceinline__ unsigned pk2(float lo, float hi) { const bf2v v = {(__bf16)lo, (__bf16)hi}; return __builtin_bit_cast(unsigned, v); }
__device__ __forceinline__ float bflo(unsigned w) { return __builtin_bit_cast(float, w << 16); }
__device__ __forceinline__ float bfhi(unsigned w) { return __builtin_bit_cast(float, w & 0xffff0000u); }
__device__ __forceinline__ float bf2f(bf16 b) { return __builtin_bit_cast(float, ((unsigned)b) << 16); }
__device__ __forceinline__ float dot2_bf16(unsigned w, unsigned x, float acc) { return __builtin_amdgcn_fdot2_f32_bf16(__builtin_bit_cast(bf16x2v, w), __builtin_bit_cast(bf16x2v, x), acc, false); }
__device__ __forceinline__ float fexp2(float x) { return __builtin_amdgcn_exp2f(x); }
__device__ __forceinline__ float frcp(float x) { return __builtin_amdgcn_rcpf(x); }
__device__ __forceinline__ float gelu_tanh(float x) {
    const float t = x * (0.7978845608028654f + 0.035677408136300125f * x * x);
    return x * frcp(1.0f + fexp2(-2.8853900817779268f * t));
}
__device__ __forceinline__ float sigmoidf_(float x) { return frcp(1.0f + fexp2(-1.4426950408889634f * x)); }
__device__ __forceinline__ float row16_sum(float v) {
    v += __builtin_bit_cast(float, __builtin_amdgcn_update_dpp(0, __builtin_bit_cast(int, v), 0xB1, 0xF, 0xF, true));
    v += __builtin_bit_cast(float, __builtin_amdgcn_update_dpp(0, __builtin_bit_cast(int, v), 0x4E, 0xF, 0xF, true));
    v += __builtin_bit_cast(float, __builtin_amdgcn_update_dpp(0, __builtin_bit_cast(int, v), 0x141, 0xF, 0xF, true));
    v += __builtin_bit_cast(float, __builtin_amdgcn_update_dpp(0, __builtin_bit_cast(int, v), 0x140, 0xF, 0xF, true));
    return v;
}

__device__ __forceinline__ float bperm(int src_lane, float v) { return __builtin_bit_cast(float, __builtin_amdgcn_ds_bpermute(src_lane << 2, __builtin_bit_cast(int, v))); }
__device__ __forceinline__ float wave_sum(float v) {
    v = row16_sum(v);
    v += __builtin_bit_cast(float, __builtin_amdgcn_update_dpp(0, __builtin_bit_cast(int, v), 0x142, 0xA, 0xF, false));
    v += __builtin_bit_cast(float, __builtin_amdgcn_update_dpp(0, __builtin_bit_cast(int, v), 0x143, 0xC, 0xF, false));
    return __builtin_bit_cast(float, __builtin_amdgcn_readlane(__builtin_bit_cast(int, v), 63));
}
__device__ __forceinline__ float wave_max(float v) {
    const int ninf = (int)0xff800000u;
    v = fmaxf(v, __builtin_bit_cast(float, __builtin_amdgcn_update_dpp(ninf, __builtin_bit_cast(int, v), 0xB1, 0xF, 0xF, false)));
    v = fmaxf(v, __builtin_bit_cast(float, __builtin_amdgcn_update_dpp(ninf, __builtin_bit_cast(int, v), 0x4E, 0xF, 0xF, false)));
    v = fmaxf(v, __builtin_bit_cast(float, __builtin_amdgcn_update_dpp(ninf, __builtin_bit_cast(int, v), 0x141, 0xF, 0xF, false)));
    v = fmaxf(v, __builtin_bit_cast(float, __builtin_amdgcn_update_dpp(ninf, __builtin_bit_cast(int, v), 0x140, 0xF, 0xF, false)));
    v = fmaxf(v, __builtin_bit_cast(float, __builtin_amdgcn_update_dpp(ninf, __builtin_bit_cast(int, v), 0x142, 0xA, 0xF, false)));
    v = fmaxf(v, __builtin_bit_cast(float, __builtin_amdgcn_update_dpp(ninf, __builtin_bit_cast(int, v), 0x143, 0xC, 0xF, false)));
    return __builtin_bit_cast(float, __builtin_amdgcn_readlane(__builtin_bit_cast(int, v), 63));
}
#define XB_TMO      128
#define XB_XCNT(j)  (256  + 64 * (j))
#define XB_XSUB(j)  (1280 + 64 * (j))
#define XB_XGEN(j)  (2304 + 64 * (j))
#define XB_TOP      3328
#define XB_TOPGEN   3392
#define XCD_BAR_WORDS 3456
#define XB_SPIN_CAP (1u << 18)

__device__ __forceinline__ unsigned xb_ld(unsigned* p)              { return __hip_atomic_load(p, __ATOMIC_RELAXED, __HIP_MEMORY_SCOPE_AGENT); }
__device__ __forceinline__ unsigned xb_add(unsigned* p, unsigned v) { return __hip_atomic_fetch_add(p, v, __ATOMIC_RELAXED, __HIP_MEMORY_SCOPE_AGENT); }
__device__ __forceinline__ unsigned xb_xcc_id() { return (unsigned)__builtin_amdgcn_s_getreg((3 << 11) | 20) & 0xFu; }
#define XB_SPIN(cond, bar) do { unsigned _sp = 0; while (cond) { __builtin_amdgcn_s_sleep(1); \
    if ((++_sp & 255u) == 0u) { if (xb_ld(&(bar)[XB_TMO])) break; if (_sp > XB_SPIN_CAP) { atomicAdd(&(bar)[XB_TMO], 1u); break; } } } } while (0)

struct XcdBarrier {
    unsigned* bar; unsigned x;
    volatile LAS unsigned* st;
};

__device__ __forceinline__ XcdBarrier xcd_barrier_post(unsigned* bar, volatile LAS unsigned* st) {
    XcdBarrier b; b.bar = bar; b.x = xb_xcc_id(); b.st = st;
    if (threadIdx.x == 0) (void)xb_add(&bar[XB_XCNT(b.x)], 1u);
    return b;
}
__device__ __forceinline__ void xcd_barrier_complete(unsigned* bar, unsigned x, unsigned& nloc, unsigned& nx) {
    const unsigned G = gridDim.x * gridDim.y * gridDim.z;
    unsigned sum, cnt, mine, sp = 0u;
    for (;;) {
        sum = 0u; cnt = 0u; mine = 0u;
#pragma unroll
        for (unsigned j = 0; j < 16; ++j) { const unsigned c = xb_ld(&bar[XB_XCNT(j)]); sum += c; cnt += (c > 0u) ? 1u : 0u; mine = (j == x) ? c : mine; }
        if (sum == G) break;
        __builtin_amdgcn_s_sleep(1);
        if ((++sp & 255u) == 0u) { if (xb_ld(&bar[XB_TMO])) break; if (sp > XB_SPIN_CAP) { atomicAdd(&bar[XB_TMO], 1u); break; } }
    }
    nloc = mine > 0u ? mine : 1u; nx = cnt > 0u ? cnt : 1u;
}

__device__ __forceinline__ void xcd_barrier(const XcdBarrier& b, int tid) {
    asm volatile("s_waitcnt vmcnt(0)" ::: "memory");
    __syncthreads();
    if (tid == 0) {
        unsigned* bar = b.bar;
        __builtin_amdgcn_s_waitcnt(0);
        unsigned nloc = b.st[0], nx = b.st[1];
        if (nloc == 0u) { xcd_barrier_complete(bar, b.x, nloc, nx); b.st[0] = nloc; b.st[1] = nx; }
        const unsigned old = xb_add(&bar[XB_XSUB(b.x)], 1u);
        const unsigned gen = old / nloc;
        if (old + 1u == (gen + 1u) * nloc) {
            __builtin_amdgcn_fence(__ATOMIC_RELEASE, "agent");
            asm volatile("s_waitcnt vmcnt(0)" ::: "memory");
            const unsigned og = xb_add(&bar[XB_TOP], 1u);
            const unsigned tg = og / nx;
            if (og + 1u == (tg + 1u) * nx) xb_add(&bar[XB_TOPGEN], 1u);
            else XB_SPIN(xb_ld(&bar[XB_TOPGEN]) == tg, bar);
            __builtin_amdgcn_fence(__ATOMIC_ACQUIRE, "agent");
            xb_add(&bar[XB_XGEN(b.x)], 1u);
            asm volatile("s_waitcnt vmcnt(0)" ::: "memory");
        } else {
            XB_SPIN(xb_ld(&bar[XB_XGEN(b.x)]) == gen, bar);
            __builtin_amdgcn_fence(__ATOMIC_ACQUIRE, "agent");
            asm volatile("s_waitcnt vmcnt(0)" ::: "memory");
        }
    }
    __syncthreads();
}

struct Frame {
    LAS unsigned char* lds;
    volatile LAS unsigned* MISC;
    gu32* ctl;
    int tid, lane, wave, G, bx;
    float* out;
    unsigned char* ws;
};
#define IN_XP 0
#define IN_XS 1
#define IN_CK 2
#define IN_CV 3
#define IN_PPR 4
#define IN_PSA 5
#define IN_LN1G 6
#define IN_LN1B 7
#define IN_LN2G 8
#define IN_LN2B 9
#define IN_WIN 10
#define IN_BIN 11
#define IN_SLNG 12
#define IN_SLNB 13
#define IN_WS 14
#define IN_BS 15
#define IN_WOUT 16
#define IN_BOUT 17
#define IN_WKV 18
#define IN_WQ 19
#define IN_SINK 20
#define IN_WO 21
#define IN_PWQ 22
#define IN_SUBK 23
#define IN_PU 24
#define IN_PV 25
#define IN_PLEW 26
#define IN_GW 27
#define IN_GB 28

typedef const GAS float* CFPtr;
__device__ __forceinline__ const float* inp(int k) {
    const __attribute__((address_space(4))) CFPtr* ka = (const __attribute__((address_space(4))) CFPtr*)__builtin_amdgcn_kernarg_segment_ptr();
    asm volatile("" : "+s"(ka));
    return (const float*)ka[k];
}

using pg8::Unit;
typedef const f32x4 (&AccRef)[2][2][4][2];

struct EpiZ {
    static constexpr bool PERM = true, AFTER_DRAIN = false;
    bf16* Z; const float* bias; float* stats;
    __device__ __forceinline__ void operator()(AccRef acc, const Unit& u, int wr, int wc, int fr, int fq) const {
        asm volatile("" : "+v"(fr), "+v"(fq));
        const int row0 = u.pm * 256 + wr * 64 + fr, col0 = u.pn * 256 + wc * 32 + 8 * fq;
        const bool isv = u.pn >= 8;
        f32x4 bv[2][2];
#pragma unroll
        for (int bj = 0; bj < 2; ++bj)
#pragma unroll
            for (int n = 0; n < 2; ++n) bv[bj][n] = *(const f32x4*)(bias + col0 + bj * 128 + 4 * n);
#pragma unroll
        for (int ai = 0; ai < 2; ++ai)
#pragma unroll
            for (int m = 0; m < 4; ++m) {
                const int row = row0 + ai * 128 + m * 16;
                float s1 = 0.f, s2 = 0.f;
#pragma unroll
                for (int bj = 0; bj < 2; ++bj) {
                    f32x4 v0 = acc[ai][bj][m][0] + bv[bj][0], v1 = acc[ai][bj][m][1] + bv[bj][1];
#pragma unroll
                    for (int e = 0; e < 4; ++e) { v0[e] = gelu_tanh(v0[e]); v1[e] = gelu_tanh(v1[e]); }
                    v4u w; w.x = pk2(v0[0], v0[1]); w.y = pk2(v0[2], v0[3]); w.z = pk2(v1[0], v1[1]); w.w = pk2(v1[2], v1[3]);
                    *(v4u*)(Z + (size_t)row * 4096 + col0 + bj * 128) = w;
                    const float r0 = bflo(w.x), r1 = bfhi(w.x), r2 = bflo(w.y), r3 = bfhi(w.y), r4 = bflo(w.z), r5 = bfhi(w.z), r6 = bflo(w.w), r7 = bfhi(w.w);
                    s1 += ((r0 + r1) + (r2 + r3)) + ((r4 + r5) + (r6 + r7));
                    s2 += ((r0 * r0 + r1 * r1) + (r2 * r2 + r3 * r3)) + ((r4 * r4 + r5 * r5) + (r6 * r6 + r7 * r7));
                }
                if (isv) {
                    const int ln = fq * 16 + fr;
                    s1 += bperm(ln ^ 16, s1); s1 += bperm(ln ^ 32, s1);
                    s2 += bperm(ln ^ 16, s2); s2 += bperm(ln ^ 32, s2);
                    if (fq == 0) *(f32x2*)(stats + ((size_t)row * 32 + (u.pn - 8) * 4 + wc) * 2) = (f32x2){s1, s2};
                }
            }
    }
};

struct EpiPre {
    static constexpr bool PERM = false, AFTER_DRAIN = false;
    bf16* pre; const bf16* hin; const float* bias;
    __device__ __forceinline__ void apply4(int row, int col, f32x4 a) const {
        const size_t o = (size_t)row * D + col;
        const f32x4 bv = bias ? *(const f32x4*)(bias + col) : (f32x4){0.f, 0.f, 0.f, 0.f};
        const v2u hw = *(const v2u*)(hin + o); const f32x4 h = (f32x4){bflo(hw.x), bfhi(hw.x), bflo(hw.y), bfhi(hw.y)};
        { const f32x4 r = h * ALPHA + a + bv; v2u w; w.x = pk2(r[0], r[1]); w.y = pk2(r[2], r[3]); *(v2u*)(pre + o) = w; }
    }
    __device__ __forceinline__ void operator()(AccRef acc, const Unit& u, int wr, int wc, int fr, int fq) const {
        asm volatile("" : "+v"(fr), "+v"(fq));
        const int row0 = u.pm * 256 + wr * 64 + fr, col0 = u.pn * 256 + wc * 32 + 4 * fq;
        f32x4 bv[2][2];
#pragma unroll
        for (int bj = 0; bj < 2; ++bj)
#pragma unroll
            for (int n = 0; n < 2; ++n) bv[bj][n] = bias ? *(const f32x4*)(bias + col0 + bj * 128 + n * 16) : (f32x4){0.f, 0.f, 0.f, 0.f};
#pragma unroll
        for (int ai = 0; ai < 2; ++ai) {
            v2u hq[4][2][2];
#pragma unroll
            for (int m = 0; m < 4; ++m)
#pragma unroll
                for (int bj = 0; bj < 2; ++bj)
#pragma unroll
                    for (int n = 0; n < 2; ++n) hq[m][bj][n] = *(const v2u*)(hin + (size_t)(row0 + ai * 128 + m * 16) * D + col0 + bj * 128 + n * 16);
#pragma unroll
            for (int m = 0; m < 4; ++m) {
                const size_t ro = (size_t)(row0 + ai * 128 + m * 16) * D + col0;
#pragma unroll
                for (int bj = 0; bj < 2; ++bj)
#pragma unroll
                    for (int n = 0; n < 2; ++n) {
                        const v2u hw = hq[m][bj][n]; const f32x4 h = (f32x4){bflo(hw.x), bfhi(hw.x), bflo(hw.y), bfhi(hw.y)};
                        { const f32x4 r = h * ALPHA + acc[ai][bj][m][n] + bv[bj][n]; v2u w; w.x = pk2(r[0], r[1]); w.y = pk2(r[2], r[3]); *(v2u*)(pre + ro + bj * 128 + n * 16) = w; }
                    }
            }
        }
    }
};

struct EpiF32 {
    static constexpr bool PERM = false, AFTER_DRAIN = false;
    unsigned* C; int ldc;
    __device__ __forceinline__ void operator()(AccRef acc, const Unit& u, int wr, int wc, int fr, int fq) const {
        asm volatile("" : "+v"(fr), "+v"(fq));
        const int row0 = u.pm * 128 + wr * 64 + fr, col0 = u.pn * 256 + wc * 32 + 4 * fq;
#pragma unroll
        for (int m = 0; m < 4; ++m) {
            unsigned* rowp = C + (size_t)(row0 + m * 16) * ldc + col0;
#pragma unroll
            for (int bj = 0; bj < 2; ++bj)
#pragma unroll
                for (int n = 0; n < 2; ++n) {
                    const f32x4 a0 = acc[0][bj][m][n], a1 = acc[1][bj][m][n];
                    *(v4u*)(rowp + bj * 128 + n * 16) = (v4u){pk2(a0[0], a1[0]), pk2(a0[1], a1[1]), pk2(a0[2], a1[2]), pk2(a0[3], a1[3])};
                }
        }
    }
};

struct EpiBf {
    static constexpr bool PERM = true, AFTER_DRAIN = false;
    bf16* O; int ldc;
    __device__ __forceinline__ void apply4(int row, int col, f32x4 a) const { v2u w; w.x = pk2(a[0], a[1]); w.y = pk2(a[2], a[3]); *(v2u*)(O + (size_t)row * ldc + col) = w; }
    __device__ __forceinline__ void operator()(AccRef acc, const Unit& u, int wr, int wc, int fr, int fq) const {
        asm volatile("" : "+v"(fr), "+v"(fq));
        const int row0 = u.pm * 256 + wr * 64 + fr, col0 = u.pn * 256 + wc * 32 + 8 * fq;
#pragma unroll
        for (int ai = 0; ai < 2; ++ai)
#pragma unroll
            for (int m = 0; m < 4; ++m) {
                bf16* rowp = O + (size_t)(row0 + ai * 128 + m * 16) * ldc + col0;
#pragma unroll
                for (int bj = 0; bj < 2; ++bj) {
                    const f32x4 v0 = acc[ai][bj][m][0], v1 = acc[ai][bj][m][1];
                    v4u w; w.x = pk2(v0[0], v0[1]); w.y = pk2(v0[2], v0[3]); w.z = pk2(v1[0], v1[1]); w.w = pk2(v1[2], v1[3]);
                    *(v4u*)(rowp + bj * 128) = w;
                }
            }
    }
};

struct EpiGate {
    static constexpr bool PERM = false, AFTER_DRAIN = false;
    const bf16* hin; bf16* hb; const bf16* pp; const float* gb; float* yout;
    __device__ __forceinline__ void apply4(int row, int col, f32x4 acc4) const {
        const size_t o = (size_t)row * D + col;
        const v2u hw = *(const v2u*)(hin + o); const f32x4 h = (f32x4){bflo(hw.x), bfhi(hw.x), bflo(hw.y), bfhi(hw.y)}; const v2u pw = *(const v2u*)(pp + o); const f32x4 a = acc4 + *(const f32x4*)(gb + col);
        f32x4 r;
        r[0] = h[0] + sigmoidf_(a[0]) * bflo(pw.x); r[1] = h[1] + sigmoidf_(a[1]) * bfhi(pw.x);
        r[2] = h[2] + sigmoidf_(a[2]) * bflo(pw.y); r[3] = h[3] + sigmoidf_(a[3]) * bfhi(pw.y);
        if (yout) { *(f32x4*)(yout + o) = r; }
        else { v2u w; w.x = pk2(r[0], r[1]); w.y = pk2(r[2], r[3]); *(v2u*)(hb + o) = w; }
    }
    __device__ __forceinline__ void operator()(AccRef acc, const Unit& u, int wr, int wc, int fr, int fq) const {
        asm volatile("" : "+v"(fr), "+v"(fq));
        const int row0 = u.pm * 256 + wr * 64 + fr, col0 = u.pn * 256 + wc * 32 + 4 * fq;
        f32x4 bv[2][2];
#pragma unroll
        for (int bj = 0; bj < 2; ++bj)
#pragma unroll
            for (int n = 0; n < 2; ++n) bv[bj][n] = *(const f32x4*)(gb + col0 + bj * 128 + n * 16);
#pragma unroll
        for (int ai = 0; ai < 2; ++ai) {
            v2u hq[4][2][2], pq[4][2][2];
#pragma unroll
            for (int m = 0; m < 4; ++m)
#pragma unroll
                for (int bj = 0; bj < 2; ++bj)
#pragma unroll
                    for (int n = 0; n < 2; ++n) { const size_t o = (size_t)(row0 + ai * 128 + m * 16) * D + col0 + bj * 128 + n * 16; hq[m][bj][n] = *(const v2u*)(hin + o); pq[m][bj][n] = *(const v2u*)(pp + o); }
#pragma unroll
            for (int m = 0; m < 4; ++m) {
                const size_t ro = (size_t)(row0 + ai * 128 + m * 16) * D + col0;
#pragma unroll
                for (int bj = 0; bj < 2; ++bj)
#pragma unroll
                    for (int n = 0; n < 2; ++n) {
                        const size_t o = ro + bj * 128 + n * 16;
                        const v2u hw = hq[m][bj][n]; const f32x4 h = (f32x4){bflo(hw.x), bfhi(hw.x), bflo(hw.y), bfhi(hw.y)};
                        const v2u pw = pq[m][bj][n];
                        const f32x4 a = acc[ai][bj][m][n] + bv[bj][n];
                        f32x4 r;
                        r[0] = h[0] + sigmoidf_(a[0]) * bflo(pw.x); r[1] = h[1] + sigmoidf_(a[1]) * bfhi(pw.x);
                        r[2] = h[2] + sigmoidf_(a[2]) * bflo(pw.y); r[3] = h[3] + sigmoidf_(a[3]) * bfhi(pw.y);
                        if (yout) { *(f32x4*)(yout + o) = r; }
                        else { v2u w; w.x = pk2(r[0], r[1]); w.y = pk2(r[2], r[3]); *(v2u*)(hb + o) = w; }
                    }
            }
        }
    }
};

struct EpiQKV {
    static constexpr bool PERM = true, AFTER_DRAIN = false;
    bf16* qb; bf16* kvb; float* out;
    __device__ __forceinline__ void apply4(int row, int col, f32x4 a) const {
        v2u w; w.x = pk2(a[0], a[1]); w.y = pk2(a[2], a[3]); *(v2u*)(qb + (size_t)row * D + col) = w;
    }
    __device__ __forceinline__ void operator()(AccRef acc, const Unit& u, int wr, int wc, int fr, int fq) const {
        asm volatile("" : "+v"(fr), "+v"(fq));
        const int row0 = u.pm * 256 + wr * 64 + fr, cl = wc * 32 + 8 * fq;
        const bool iskv = u.pn >= 4;
#pragma unroll
        for (int ai = 0; ai < 2; ++ai)
#pragma unroll
            for (int m = 0; m < 4; ++m) {
                const int row = row0 + ai * 128 + m * 16;
#pragma unroll
                for (int bj = 0; bj < 2; ++bj) {
                    const f32x4 v0 = acc[ai][bj][m][0], v1 = acc[ai][bj][m][1];
                    v4u w; w.x = pk2(v0[0], v0[1]); w.y = pk2(v0[2], v0[3]); w.z = pk2(v1[0], v1[1]); w.w = pk2(v1[2], v1[3]);
                    const int c = cl + bj * 128;
                    if (!iskv) { *(v4u*)(qb + (size_t)row * D + u.pn * 256 + c) = w; }
                    else {
                        *(v4u*)(kvb + (size_t)row * 256 + c) = w;
                        long widx = -1;
                        size_t base = 0;
                        if (row < TP) { const int s = row & 8191; if (s >= 8064) { widx = (long)(row >> 13) * 128 + (s - 8064); base = (bj == 0) ? O_KP : O_VP; } }
                        else { const int r = row - TP; widx = (long)(r >> 3) * 128 + 120 + (r & 7); base = (bj == 0) ? O_KS : O_VS; }
                        if (widx >= 0) { float* o = out + base + (size_t)widx * 128 + cl; *(f32x4*)o = v0; *(f32x4*)(o + 4) = v1; }
                    }
                }
            }
    }
};

template <class Epi>
__device__ __forceinline__ void sgemm64(Frame& F, const bf16* A, const bf16* Bt, int row_base, int nrt, int nct, int K, const Epi& E) {
    constexpr int PS = 68;
    LAS float* part = (LAS float*)F.lds;
    const int lane = F.lane, fr = lane & 15, fq = lane >> 4, wk = F.wave & 3, wm = F.wave >> 2, kper = K / 4;
    for (int tile = F.bx; tile < nrt * nct; tile += F.G) {
        const int rt = tile / nct, ct = tile % nct, r0 = row_base + rt * 64, c0 = ct * 64;
        f32x4 acc[2][4];
#pragma unroll
        for (int mt = 0; mt < 2; ++mt)
#pragma unroll
            for (int nt = 0; nt < 4; ++nt) acc[mt][nt] = (f32x4){0.f, 0.f, 0.f, 0.f};
        const bf16* Ap = A + (size_t)(r0 + wm * 32 + fr) * K + wk * kper + fq * 8;
        const bf16* Bp = Bt + (size_t)(c0 + fr) * K + wk * kper + fq * 8;
#pragma unroll 4
        for (int ks = 0; ks < kper / 32; ++ks) {
            bf16x8 af[2], bfr[4];
#pragma unroll
            for (int mt = 0; mt < 2; ++mt) af[mt] = *(const bf16x8*)(Ap + (size_t)mt * 16 * K + ks * 32);
#pragma unroll
            for (int nt = 0; nt < 4; ++nt) bfr[nt] = *(const bf16x8*)(Bp + (size_t)nt * 16 * K + ks * 32);
#pragma unroll
            for (int mt = 0; mt < 2; ++mt)
#pragma unroll
                for (int nt = 0; nt < 4; ++nt) acc[mt][nt] = __builtin_amdgcn_mfma_f32_16x16x32_bf16(bfr[nt], af[mt], acc[mt][nt], 0, 0, 0);
        }
#pragma unroll
        for (int mt = 0; mt < 2; ++mt)
#pragma unroll
            for (int nt = 0; nt < 4; ++nt) *(LAS f32x4*)(part + (size_t)((wk * 64 + wm * 32 + mt * 16 + fr) * PS + nt * 16 + 4 * fq)) = acc[mt][nt];
        __syncthreads();
        {
            const int row = F.tid >> 3, cg = (F.tid & 7) * 8;
            f32x4 s0 = (f32x4){0.f, 0.f, 0.f, 0.f}, s1 = (f32x4){0.f, 0.f, 0.f, 0.f};
#pragma unroll
            for (int w = 0; w < 4; ++w) { s0 += *(const LAS f32x4*)(part + (size_t)((w * 64 + row) * PS + cg)); s1 += *(const LAS f32x4*)(part + (size_t)((w * 64 + row) * PS + cg + 4)); }
            E.apply4(r0 + row, c0 + cg, s0); E.apply4(r0 + row, c0 + cg + 4, s1);
        }
        __syncthreads();
    }
}

__device__ __forceinline__ void p0_transpose_item(const float* W, int K, int N, bf16* WT, int row_off, LAS float* scr, int item, int lane) {
    const int nblk = N / 32, kb = item / nblk, nb = item % nblk, k0 = 64 * kb, n0 = 32 * nb;
    float tv[32];
#pragma unroll
    for (int i = 0; i < 32; ++i) { const int kk = 2 * i + (lane >> 5); tv[i] = W[(size_t)(k0 + kk) * N + n0 + (lane & 31)]; }
#pragma unroll
    for (int i = 0; i < 32; ++i) { const int kk = 2 * i + (lane >> 5); scr[kk * 33 + (lane & 31)] = tv[i]; }
    LDS_WAIT(); asm volatile("" ::: "memory");
    const int c = lane & 7;
#pragma unroll
    for (int j = 0; j < 4; ++j) { const int n = (lane >> 3) + 8 * j; const LAS float* s = scr + (8 * c) * 33 + n;
        v4u o; o.x = pk2(s[0 * 33], s[1 * 33]); o.y = pk2(s[2 * 33], s[3 * 33]); o.z = pk2(s[4 * 33], s[5 * 33]); o.w = pk2(s[6 * 33], s[7 * 33]);
        *(v4u*)(WT + (size_t)(row_off + n0 + n) * K + k0 + 8 * c) = o; }
    LDS_WAIT(); asm volatile("" ::: "memory");
}
__device__ __forceinline__ void p0_cvt(const float* src, bf16* dst, size_t n8, size_t gt, size_t ngt) {
    for (size_t i = gt; i < n8; i += 4 * ngt) {
        f32x4 a[4], b[4];
#pragma unroll
        for (int r = 0; r < 4; ++r) { const size_t j = (i + r * ngt < n8) ? i + r * ngt : i; a[r] = *(const f32x4*)(src + j * 8); b[r] = *(const f32x4*)(src + j * 8 + 4); }
#pragma unroll
        for (int r = 0; r < 4; ++r) {
            if (i + r * ngt < n8) {
                v4u w; w.x = pk2(a[r][0], a[r][1]); w.y = pk2(a[r][2], a[r][3]); w.z = pk2(b[r][0], b[r][1]); w.w = pk2(b[r][2], b[r][3]);
                *(v4u*)(dst + (i + r * ngt) * 8) = w;
            }
        }
    }
}
__device__ __forceinline__ void p0_cvt8(const float* src, unsigned char* dst, size_t n16, float scale, size_t gt, size_t ngt) {
    for (size_t i = gt; i < n16; i += 4 * ngt) {
        f32x4 a[4][4];
#pragma unroll
        for (int r = 0; r < 4; ++r) { const size_t j = (i + r * ngt < n16) ? i + r * ngt : i;
#pragma unroll
            for (int c = 0; c < 4; ++c) a[r][c] = *(const f32x4*)(src + j * 16 + 4 * c); }
#pragma unroll
        for (int r = 0; r < 4; ++r) {
            if (i + r * ngt < n16) {
                v4u w;
#pragma unroll
                for (int c = 0; c < 4; ++c) {
                    const f32x4 q = a[r][c] * scale;
                    int x = __builtin_amdgcn_cvt_pk_fp8_f32(q[0], q[1], 0, false);
                    x = __builtin_amdgcn_cvt_pk_fp8_f32(q[2], q[3], x, true);
                    w[c] = (unsigned)x;
                }
                *(v4u*)(dst + (i + r * ngt) * 16) = w;
            }
        }
    }
}
__device__ __forceinline__ void table_filler(Frame& F, int layer, int which, int nwg) {
    const int rem = nwg % F.G;
    int k = F.bx, n = F.G;
    if (rem) { if (F.bx < rem) return; k = F.bx - rem; n = F.G - rem; }
    const float* src = inp(which ? IN_PV : IN_PU) + (size_t)layer * NEXP * D;
    unsigned char* dst = (unsigned char*)(F.ws + (which ? WS_PV : WS_PU)) + (size_t)layer * NEXP * D;
    p0_cvt8(src, dst, (size_t)NEXP * D / 16, which ? 16.f : 64.f, (size_t)k * 512 + F.tid, (size_t)n * 512);
}
__device__ __forceinline__ void phase_prologue(Frame& F) {
    unsigned char* ws = F.ws;
    const int gw = F.bx * NWAVES + F.wave, NGW = F.G * NWAVES;
    const size_t gt = (size_t)F.bx * 512 + F.tid, ngt = (size_t)F.G * 512;
    LAS float* scr = (LAS float*)(F.lds + F.wave * 16384);
    {
        constexpr int I_WIN = (1024 / 64) * (4096 / 32), I_WOUT = (2048 / 64) * (1024 / 32), I_SQ = (1024 / 64) * (1024 / 32), I_KV = (1024 / 64) * (256 / 32), I_PLE = (256 / 64) * (1024 / 32);
        constexpr int NIT = 2 * I_WIN + 2 * I_WOUT + 2 * I_SQ + I_KV + 2 * I_SQ + 4 * I_PLE + 4 * I_SQ;
        for (int it = gw; it < NIT; it += NGW) {
            int r = it;
            if (r < 2 * I_WIN) { const int l = r / I_WIN; p0_transpose_item(inp(IN_WIN) + (size_t)l * 1024 * 4096, 1024, 4096, (bf16*)(ws + WS_WIN) + (size_t)l * 4096 * 1024, 0, scr, r % I_WIN, F.lane); continue; } r -= 2 * I_WIN;
            if (r < 2 * I_WOUT) { const int l = r / I_WOUT; p0_transpose_item(inp(IN_WOUT) + (size_t)l * 2048 * 1024, 2048, 1024, (bf16*)(ws + WS_WOUT) + (size_t)l * 1024 * 2048, 0, scr, r % I_WOUT, F.lane); continue; } r -= 2 * I_WOUT;
            if (r < I_SQ) { p0_transpose_item(inp(IN_WQ), 1024, 1024, (bf16*)(ws + WS_WQKV), 0, scr, r, F.lane); continue; } r -= I_SQ;
            if (r < I_SQ) { p0_transpose_item(inp(IN_WQ) + (size_t)1024 * 1024, 1024, 1024, (bf16*)(ws + WS_WQ1), 0, scr, r, F.lane); continue; } r -= I_SQ;
            if (r < I_KV) { p0_transpose_item(inp(IN_WKV), 1024, 256, (bf16*)(ws + WS_WQKV), 1024, scr, r, F.lane); continue; } r -= I_KV;
            if (r < 2 * I_SQ) { const int l = r / I_SQ; p0_transpose_item(inp(IN_WO) + (size_t)l * 1024 * 1024, 1024, 1024, (bf16*)(ws + WS_WO) + (size_t)l * 1024 * 1024, 0, scr, r % I_SQ, F.lane); continue; } r -= 2 * I_SQ;
            if (r < 4 * I_PLE) { const int l = r / I_PLE; p0_transpose_item(inp(IN_PLEW) + (size_t)l * 256 * 1024, 256, 1024, (bf16*)(ws + WS_PLE) + (size_t)l * 1024 * 256, 0, scr, r % I_PLE, F.lane); continue; } r -= 4 * I_PLE;
            { const int l = r / I_SQ; p0_transpose_item(inp(IN_GW) + (size_t)l * 1024 * 1024, 1024, 1024, (bf16*)(ws + WS_GATE) + (size_t)l * 1024 * 1024, 0, scr, r % I_SQ, F.lane); }
        }
    }
    __syncthreads();
    {
        LAS float* sk = (LAS float*)F.lds;
        LAS float* wq = (LAS float*)(F.lds + 128 * 132 * 4);
        for (int it = F.bx; it < 1024; it += F.G) {
            const int l = it >> 8, hp = (it >> 4) & 15, dc = it & 15, p = hp & 1;
            const float* skg = inp(IN_SUBK) + ((size_t)(l * 2 + p) * 128) * 128;
            const float* wqg = inp(IN_PWQ) + (size_t)l * 1024 * 2048 + (size_t)(dc * 64) * 2048 + hp * 128;
            for (int i = F.tid; i < 128 * 32; i += 512) *(LAS f32x4*)(sk + (i >> 5) * 132 + (i & 31) * 4) = *(const f32x4*)(skg + (size_t)i * 4);
            for (int i = F.tid; i < 64 * 32; i += 512) *(LAS f32x4*)(wq + (i >> 5) * 132 + (i & 31) * 4) = *(const f32x4*)(wqg + (size_t)(i >> 5) * 2048 + (i & 31) * 4);
            __syncthreads();
            const int ng = F.tid & 31, dg = F.tid >> 5;
            float a[4][4];
#pragma unroll
            for (int ni = 0; ni < 4; ++ni)
#pragma unroll
                for (int di = 0; di < 4; ++di) a[ni][di] = 0.f;
            for (int c4 = 0; c4 < 32; ++c4) {
                f32x4 sv[4], wv[4];
#pragma unroll
                for (int ni = 0; ni < 4; ++ni) sv[ni] = *(const LAS f32x4*)(sk + (ng + 32 * ni) * 132 + 4 * c4);
#pragma unroll
                for (int di = 0; di < 4; ++di) wv[di] = *(const LAS f32x4*)(wq + (4 * dg + di) * 132 + 4 * c4);
#pragma unroll
                for (int ni = 0; ni < 4; ++ni)
#pragma unroll
                    for (int di = 0; di < 4; ++di)
                        a[ni][di] += (sv[ni][0] * wv[di][0] + sv[ni][1] * wv[di][1]) + (sv[ni][2] * wv[di][2] + sv[ni][3] * wv[di][3]);
            }
#pragma unroll
            for (int ni = 0; ni < 4; ++ni) {
                bf16* o = (bf16*)(ws + WS_WQK) + ((size_t)l * 2048 + hp * 128 + ng + 32 * ni) * 1024 + dc * 64 + 4 * dg;
                v2u w0; w0.x = pk2(a[ni][0], a[ni][1]); w0.y = pk2(a[ni][2], a[ni][3]);
                *(v2u*)o = w0;
            }
            __syncthreads();
        }
    }
    for (int l = 0; l < 4; ++l) {
        p0_cvt(inp(IN_PPR) + (size_t)l * TP * DPLE, (bf16*)(ws + WS_PBF) + (size_t)l * T * DPLE, (size_t)TP * DPLE / 8, gt, ngt);
        p0_cvt(inp(IN_PSA) + (size_t)l * TS * DPLE, (bf16*)(ws + WS_PBF) + ((size_t)l * T + TP) * DPLE, (size_t)TS * DPLE / 8, gt, ngt);
    }
    {
        bf16* hb = (bf16*)(ws + WS_HB);
        for (size_t i0 = gt; i0 < (size_t)T * D / 8; i0 += 4 * ngt) {
            f32x4 a[4], b[4];
#pragma unroll
            for (int r = 0; r < 4; ++r) { const size_t i = (i0 + r * ngt < (size_t)T * D / 8) ? i0 + r * ngt : i0;
                const float* src = (i < (size_t)TP * D / 8) ? inp(IN_XP) + i * 8 : inp(IN_XS) + (i * 8 - (size_t)TP * D);
                a[r] = *(const f32x4*)src; b[r] = *(const f32x4*)(src + 4); }
#pragma unroll
            for (int r = 0; r < 4; ++r) { const size_t i = i0 + r * ngt;
                if (i < (size_t)T * D / 8) {
                    v4u w; w.x = pk2(a[r][0], a[r][1]); w.y = pk2(a[r][2], a[r][3]); w.z = pk2(b[r][0], b[r][1]); w.w = pk2(b[r][2], b[r][3]);
                    *(v4u*)(hb + i * 8) = w;
                } }
        }
    }
    {
        bf16* wsb = (bf16*)(ws + WS_WSB);
        for (size_t i = gt; i < (size_t)2 * 2 * 8 * 128 * 128; i += ngt) {
            const int s = (int)(i & 127), t = (int)((i >> 7) & 127), g = (int)((i >> 14) & 7), var = (int)((i >> 17) & 1), l = (int)(i >> 18);
            const float* w = inp(IN_WS) + ((size_t)(l * 8 + g) * 128) * 128;
            float v;
            if (var == 0) v = (s <= t) ? w[t * 128 + s] : 0.f;
            else v = ((t >> 3) == (s >> 3) && (s & 7) <= (t & 7)) ? w[(t & 7) * 128 + (s & 7)] : 0.f;
            wsb[i] = (bf16)f2bf(v);
        }
    }
    for (size_t i = gt; i < (size_t)128 * 120 * 128 / 4; i += ngt) {
        const size_t e = i * 4, db = e / (120 * 128), rem = e % (120 * 128);
        *(f32x4*)(F.out + O_KS + db * 128 * 128 + rem) = *(const f32x4*)(inp(IN_CK) + db * 128 * 128 + 8 * 128 + rem);
        *(f32x4*)(F.out + O_VS + db * 128 * 128 + rem) = *(const f32x4*)(inp(IN_CV) + db * 128 * 128 + 8 * 128 + rem);
    }
}

__device__ __forceinline__ void phase_spatial(Frame& F, int layer) {
    unsigned char* ws = F.ws;
    const bf16* Z = (const bf16*)(ws + WS_Z);
    const float* stats = (const float*)(ws + WS_STATS);
    const float* lng = inp(IN_SLNG) + layer * DSGU; const float* lnb = inp(IN_SLNB) + layer * DSGU;
    const float* bs = inp(IN_BS) + layer * 8 * 128;
    const bf16* wsb = (const bf16*)(ws + WS_WSB) + (size_t)layer * 2 * 8 * 128 * 128;
    bf16* gated = (bf16*)(ws + WS_GATED);
    float* osgu = F.out + O_SGU + (size_t)layer * TS * DSGU;
    constexpr int VS = 576, WSS = 272;
    LAS unsigned char* Wl = F.lds + 128 * VS + 1024;
    LAS f32x2* sttab = (LAS f32x2*)(F.lds + 128 * VS);
    const int lane = F.lane, w = F.wave, fr = lane & 15, fq = lane >> 4, q4 = (lane & 15) >> 2, p4 = lane & 3;
    int wvar = -1;
    for (int unit = F.bx; unit < 136 * 8; unit += F.G) {
        const int mt = unit >> 3, g = unit & 7, tok0 = mt * 128; const bool samp = mt >= 128;
        f32x4 pr[4];
#pragma unroll
        for (int k = 0; k < 4; ++k) pr[k] = *(const f32x4*)(stats + (size_t)(tok0 + (F.tid >> 2)) * 64 + (F.tid & 3) * 16 + 4 * k);
        v4u raw[8];
#pragma unroll
        for (int i = 0; i < 8; ++i) { const int id = F.tid + 512 * i, s = id >> 5, ch = id & 31; raw[i] = *(const v4u*)(Z + (size_t)(tok0 + s) * 4096 + 2048 + g * 256 + ch * 8); }
        v4u uu[8];
#pragma unroll
        for (int tt = 0; tt < 8; ++tt) uu[tt] = *(const v4u*)(Z + (size_t)(tok0 + 16 * tt + fr) * 4096 + g * 256 + 32 * w + 8 * fq);
        if (wvar != (samp ? 8 : 0) + g) {
            wvar = (samp ? 8 : 0) + g;
            const bf16* wg = wsb + ((size_t)wvar * 128) * 128;
#pragma unroll
            for (int i = 0; i < 4; ++i) { const int id = F.tid + 512 * i, r = id >> 4, ch = id & 15; *(LAS v4u*)(Wl + r * WSS + ch * 16) = *(const v4u*)(wg + (size_t)r * 128 + ch * 8); }
        }
        {
            float s1 = 0.f, s2 = 0.f;
#pragma unroll
            for (int k = 0; k < 4; ++k) { s1 += pr[k][0]; s2 += pr[k][1]; s1 += pr[k][2]; s2 += pr[k][3]; }
            s1 += __builtin_bit_cast(float, __builtin_amdgcn_update_dpp(0, __builtin_bit_cast(int, s1), 0xB1, 0xF, 0xF, true));
            s2 += __builtin_bit_cast(float, __builtin_amdgcn_update_dpp(0, __builtin_bit_cast(int, s2), 0xB1, 0xF, 0xF, true));
            s1 += __builtin_bit_cast(float, __builtin_amdgcn_update_dpp(0, __builtin_bit_cast(int, s1), 0x4E, 0xF, 0xF, true));
            s2 += __builtin_bit_cast(float, __builtin_amdgcn_update_dpp(0, __builtin_bit_cast(int, s2), 0x4E, 0xF, 0xF, true));
            const float mean = s1 * (1.f / DSGU), var = fmaxf(s2 * (1.f / DSGU) - mean * mean, 0.f);
            if ((F.tid & 3) == 0) sttab[F.tid >> 2] = (f32x2){mean, __builtin_amdgcn_rsqf(var + LN_EPS)};
        }
        __syncthreads();
#pragma unroll
        for (int i = 0; i < 8; ++i) {
            const int id = F.tid + 512 * i, s = id >> 5, ch = id & 31, tok = tok0 + s, col = g * 256 + ch * 8;
            const f32x2 st = sttab[s];
            const float mean = st.x, rstd = st.y;
            const f32x4 g0 = *(const f32x4*)(lng + col), g1 = *(const f32x4*)(lng + col + 4), b0 = *(const f32x4*)(lnb + col), b1 = *(const f32x4*)(lnb + col + 4);
            f32x4 y0, y1;
            y0[0] = (bflo(raw[i].x) - mean) * rstd * g0[0] + b0[0]; y0[1] = (bfhi(raw[i].x) - mean) * rstd * g0[1] + b0[1];
            y0[2] = (bflo(raw[i].y) - mean) * rstd * g0[2] + b0[2]; y0[3] = (bfhi(raw[i].y) - mean) * rstd * g0[3] + b0[3];
            y1[0] = (bflo(raw[i].z) - mean) * rstd * g1[0] + b1[0]; y1[1] = (bfhi(raw[i].z) - mean) * rstd * g1[1] + b1[1];
            y1[2] = (bflo(raw[i].w) - mean) * rstd * g1[2] + b1[2]; y1[3] = (bfhi(raw[i].w) - mean) * rstd * g1[3] + b1[3];
            v4u o; o.x = pk2(y0[0], y0[1]); o.y = pk2(y0[2], y0[3]); o.z = pk2(y1[0], y1[1]); o.w = pk2(y1[2], y1[3]);
            *(LAS v4u*)(F.lds + s * VS + ch * 16) = o;
            if (samp) { float* op = osgu + (size_t)(tok - TP) * DSGU + col; *(f32x4*)op = y0; *(f32x4*)(op + 4) = y1; }
        }
        __syncthreads();
        f32x4 acc[8][2];
#pragma unroll
        for (int tt = 0; tt < 8; ++tt) { acc[tt][0] = (f32x4){0.f, 0.f, 0.f, 0.f}; acc[tt][1] = (f32x4){0.f, 0.f, 0.f, 0.f}; }
        const unsigned vbase = (unsigned)(uintptr_t)(F.lds) + (unsigned)((8 * fq + q4) * VS + (32 * w + 8 * p4) * 2);
#pragma unroll
        for (int ks = 0; ks < 4; ++ks) {
            s16x4 lo0, hi0, lo1, hi1;
            const unsigned a0 = vbase + ks * 32 * VS;
            asm volatile("ds_read_b64_tr_b16 %0, %4\n\tds_read_b64_tr_b16 %1, %4 offset:2304\n\tds_read_b64_tr_b16 %2, %4 offset:8\n\tds_read_b64_tr_b16 %3, %4 offset:2312\n\ts_waitcnt lgkmcnt(0)"
                         : "=&v"(lo0), "=&v"(hi0), "=&v"(lo1), "=&v"(hi1) : "v"(a0) : "memory");
            const bf16x8 vf0 = (bf16x8){lo0[0], lo0[1], lo0[2], lo0[3], hi0[0], hi0[1], hi0[2], hi0[3]};
            const bf16x8 vf1 = (bf16x8){lo1[0], lo1[1], lo1[2], lo1[3], hi1[0], hi1[1], hi1[2], hi1[3]};
#pragma unroll
            for (int tt = 0; tt < 8; ++tt) {
                if (16 * tt + 15 >= 32 * ks) {
                    const bf16x8 wf = *(const LAS bf16x8*)(Wl + (16 * tt + fr) * WSS + (32 * ks + 8 * fq) * 2);
                    acc[tt][0] = __builtin_amdgcn_mfma_f32_16x16x32_bf16(vf0, wf, acc[tt][0], 0, 0, 0);
                    acc[tt][1] = __builtin_amdgcn_mfma_f32_16x16x32_bf16(vf1, wf, acc[tt][1], 0, 0, 0);
                }
            }
        }
#pragma unroll
        for (int tt = 0; tt < 8; ++tt) {
            const int t = 16 * tt + fr, tok = tok0 + t;
            const float bias = bs[g * 128 + (samp ? (t & 7) : t)];
            const size_t col = (size_t)g * 256 + 32 * w + 8 * fq;
            v4u o;
            o.x = pk2(bflo(uu[tt].x) * (acc[tt][0][0] + bias), bfhi(uu[tt].x) * (acc[tt][0][1] + bias));
            o.y = pk2(bflo(uu[tt].y) * (acc[tt][0][2] + bias), bfhi(uu[tt].y) * (acc[tt][0][3] + bias));
            o.z = pk2(bflo(uu[tt].z) * (acc[tt][1][0] + bias), bfhi(uu[tt].z) * (acc[tt][1][1] + bias));
            o.w = pk2(bflo(uu[tt].w) * (acc[tt][1][2] + bias), bfhi(uu[tt].w) * (acc[tt][1][3] + bias));
            *(v4u*)(gated + (size_t)tok * DSGU + col) = o;
        }
        __syncthreads();
    }
}

__device__ __forceinline__ void phase_ln1(Frame& F, int layer, bf16* hb) {
    unsigned char* ws = F.ws;
    const bf16* pre = (const bf16*)(ws + WS_PRE);
    const float* gg = inp(IN_LN1G) + layer * D; const float* bb = inp(IN_LN1B) + layer * D;
    const int gw = F.bx * NWAVES + F.wave, NGW = F.G * NWAVES, lane = F.lane;
    f32x4 gv[4], bv[4];
#pragma unroll
    for (int j = 0; j < 4; ++j) { gv[j] = *(const f32x4*)(gg + 4 * lane + 256 * j); bv[j] = *(const f32x4*)(bb + 4 * lane + 256 * j); }
    for (int m0 = gw; m0 < T; m0 += 9 * NGW) {
        f32x4 v[9][4];
#pragma unroll
        for (int r = 0; r < 9; ++r) { const int m = (m0 + r * NGW < T) ? m0 + r * NGW : m0;
#pragma unroll
            for (int j = 0; j < 4; ++j) { const v2u pw = *(const v2u*)(pre + (size_t)m * D + 4 * lane + 256 * j); v[r][j] = (f32x4){bflo(pw.x), bfhi(pw.x), bflo(pw.y), bfhi(pw.y)}; } }
#pragma unroll
        for (int r = 0; r < 9; ++r) {
            const int m = m0 + r * NGW;
            float s = 0.f;
#pragma unroll
            for (int j = 0; j < 4; ++j) s += (v[r][j][0] + v[r][j][1]) + (v[r][j][2] + v[r][j][3]);
            const float mean = wave_sum(s) * (1.f / D); float s2 = 0.f;
#pragma unroll
            for (int j = 0; j < 4; ++j) { v[r][j] = v[r][j] - mean; s2 += (v[r][j][0] * v[r][j][0] + v[r][j][1] * v[r][j][1]) + (v[r][j][2] * v[r][j][2] + v[r][j][3] * v[r][j][3]); }
            const float rstd = __builtin_amdgcn_rsqf(wave_sum(s2) * (1.f / D) + LN_EPS);
            if (m < T) {
#pragma unroll
                for (int j = 0; j < 4; ++j) {
                    const f32x4 y = v[r][j] * rstd * gv[j] + bv[j];
                    v2u o; o.x = pk2(y[0], y[1]); o.y = pk2(y[2], y[3]);
                    *(v2u*)(hb + (size_t)m * D + 4 * lane + 256 * j) = o;
                }
            }
        }
    }
}

__device__ __forceinline__ unsigned f2key(float s) { const unsigned u = __builtin_bit_cast(unsigned, s); return (u & 0x80000000u) ? ~u : (u | 0x80000000u); }
__device__ __forceinline__ float key2f(unsigned k, unsigned mask) { const unsigned u = (k & 0x80000000u) ? (k & 0x7fffffffu) : ~k; return __builtin_bit_cast(float, u & ~mask); }
__device__ __forceinline__ void ce_desc(unsigned& x, unsigned& y) { const unsigned hi = x > y ? x : y, lo = x > y ? y : x; x = hi; y = lo; }
__device__ __forceinline__ void sort16(unsigned (&a)[16]) {
#pragma unroll
    for (int k = 2; k <= 16; k <<= 1)
#pragma unroll
        for (int j = k >> 1; j > 0; j >>= 1)
#pragma unroll
            for (int i = 0; i < 16; ++i) { const int l = i ^ j; if (l > i) { if ((i & k) == 0) ce_desc(a[i], a[l]); else ce_desc(a[l], a[i]); } }
}
__device__ __forceinline__ void merge16(unsigned (&top)[16], const unsigned (&g)[16]) {
#pragma unroll
    for (int i = 0; i < 16; ++i) top[i] = top[i] > g[15 - i] ? top[i] : g[15 - i];
#pragma unroll
    for (int j = 8; j > 0; j >>= 1)
#pragma unroll
        for (int i = 0; i < 16; ++i) { const int l = i ^ j; if (l > i) ce_desc(top[i], top[l]); }
}
__device__ __forceinline__ void top16_of_128(const unsigned* sp, int p, unsigned (&top)[16]) {
    unsigned nx[16];
#pragma unroll
    for (int i = 0; i < 16; ++i) nx[i] = sp[(size_t)i * T];
#pragma unroll 1
    for (int grp = 0; grp < 8; ++grp) {
        unsigned g[16];
#pragma unroll
        for (int i = 0; i < 16; ++i) g[i] = (f2key(p ? bfhi(nx[i]) : bflo(nx[i])) & ~127u) | (unsigned)(127 - (grp * 16 + i));
        if (grp < 7) {
#pragma unroll
            for (int i = 0; i < 16; ++i) nx[i] = sp[(size_t)((grp + 1) * 16 + i) * T];
        }
        sort16(g);
        if (grp == 0) {
#pragma unroll
            for (int i = 0; i < 16; ++i) top[i] = g[i];
        } else merge16(top, g);
    }
}
__device__ __forceinline__ void top16x2_of_128(const unsigned* sp, unsigned (&t1)[16], unsigned (&t2)[16]) {
    unsigned nx[16];
#pragma unroll
    for (int i = 0; i < 16; ++i) nx[i] = sp[(size_t)i * T];
#pragma unroll 1
    for (int grp = 0; grp < 8; ++grp) {
        unsigned g1[16], g2[16];
#pragma unroll
        for (int i = 0; i < 16; ++i) { const unsigned ix = (unsigned)(127 - (grp * 16 + i)); g1[i] = (f2key(bflo(nx[i])) & ~127u) | ix; g2[i] = (f2key(bfhi(nx[i])) & ~127u) | ix; }
        if (grp < 7) {
#pragma unroll
            for (int i = 0; i < 16; ++i) nx[i] = sp[(size_t)((grp + 1) * 16 + i) * T];
        }
        sort16(g1); sort16(g2);
        if (grp == 0) {
#pragma unroll
            for (int i = 0; i < 16; ++i) { t1[i] = g1[i]; t2[i] = g2[i]; }
        } else { merge16(t1, g1); merge16(t2, g2); }
    }
}
__device__ __forceinline__ void phase_topk(Frame& F) {
    unsigned char* ws = F.ws;
    const unsigned* SC = (const unsigned*)(ws + WS_SC);
    int* eidx = (int*)(ws + WS_EIDX); float* gwt = (float*)(ws + WS_GW);
    LAS unsigned char* ib = F.lds + F.tid * 32;
    const int tpb = (T + F.G - 1) / F.G, t0 = F.bx * tpb, cnt = (T - t0) < tpb ? (T - t0 > 0 ? T - t0 : 0) : tpb;
    const int nit = cnt * 8, left = nit > 512 ? nit - 512 : 0;
    const bool split16 = (left == 32);
    const bool pairs = !split16 && left > 0 && left <= 256;
    for (int rnd = 0; rnd < 2; ++rnd) {
        int it; bool act, wr; int pp = 0;
        if (rnd == 0) { it = F.tid; act = it < nit; wr = act; }
        else if (split16) { it = 512 + (F.tid >> 4); act = true; wr = (F.tid & 15) == 0; }
        else if (pairs) { it = 512 + (F.tid >> 1); pp = F.tid & 1; act = (F.tid >> 1) < left; wr = act && pp == 0; }
        else { it = 512 + F.tid; act = it < nit; wr = act; }
        if (rnd == 1 && left == 0) break;
        if (__builtin_amdgcn_readfirstlane(__ballot(act) == 0ull ? 1 : 0)) continue;
        const int itc = act ? it : 0;
        const int h = itc / cnt, t = t0 + itc % cnt;
        unsigned l1[16], l2[16];
        if (rnd == 1 && split16) {
            const int lst = (F.tid >> 3) & 1, part = F.tid & 7;
            const unsigned* sp = SC + (size_t)(h * 128 + part * 16) * T + t;
            unsigned g[16], o[16];
#pragma unroll
            for (int i = 0; i < 16; ++i) { const unsigned w = sp[(size_t)i * T]; g[i] = (f2key(lst ? bfhi(w) : bflo(w)) & ~127u) | (unsigned)(127 - (part * 16 + i)); }
            sort16(g);
#pragma unroll
            for (int i = 0; i < 16; ++i) o[i] = (unsigned)__builtin_amdgcn_update_dpp(0, (int)g[i], 0xB1, 0xF, 0xF, true);
            merge16(g, o);
#pragma unroll
            for (int i = 0; i < 16; ++i) o[i] = (unsigned)__builtin_amdgcn_update_dpp(0, (int)g[i], 0x4E, 0xF, 0xF, true);
            merge16(g, o);
#pragma unroll
            for (int i = 0; i < 16; ++i) o[i] = (unsigned)__builtin_amdgcn_ds_bpermute((F.lane ^ 4) << 2, (int)g[i]);
            merge16(g, o);
#pragma unroll
            for (int i = 0; i < 16; ++i) o[i] = (unsigned)__builtin_amdgcn_update_dpp(0, (int)g[i], 0x128, 0xF, 0xF, true);
#pragma unroll
            for (int i = 0; i < 16; ++i) { l1[i] = lst ? o[i] : g[i]; l2[i] = lst ? g[i] : o[i]; }
        } else if (rnd == 1 && pairs) {
            top16_of_128(SC + (size_t)(h * 128) * T + t, pp, l1);
#pragma unroll
            for (int i = 0; i < 16; ++i) l2[i] = (unsigned)__builtin_amdgcn_update_dpp(0, (int)l1[i], 0xB1, 0xF, 0xF, true);
            if (pp) {
#pragma unroll
                for (int i = 0; i < 16; ++i) { const unsigned x = l1[i]; l1[i] = l2[i]; l2[i] = x; }
            }
        } else {
            top16x2_of_128(SC + (size_t)(h * 128) * T + t, l1, l2);
        }
        float v1[16], v2[16];
#pragma unroll
        for (int i = 0; i < 16; ++i) { v1[i] = key2f(l1[i], 127u); v2[i] = key2f(l2[i], 127u); ib[i] = (unsigned char)(127u - (l1[i] & 127u)); ib[16 + i] = (unsigned char)(127u - (l2[i] & 127u)); }
        unsigned c[4][16];
        {
            int k = 0;
#pragma unroll
            for (int a = 0; a < 16; ++a)
#pragma unroll
                for (int b = 0; b < 16; ++b)
                    if ((a + 1) * (b + 1) <= 16) { c[k >> 4][k & 15] = (f2key(v1[a] + v2[b]) & ~255u) | (unsigned)(255 - (16 * a + b)); ++k; }
#pragma unroll
            for (; k < 64; ++k) c[k >> 4][k & 15] = 0u;
        }
        sort16(c[0]); sort16(c[1]); sort16(c[2]); sort16(c[3]);
        merge16(c[0], c[1]); merge16(c[0], c[2]); merge16(c[0], c[3]);
        float e[16], sum = 0.f; const float mx = key2f(c[0][0], 255u);
#pragma unroll
        for (int i = 0; i < 16; ++i) { e[i] = fexp2((key2f(c[0][i], 255u) - mx) * 1.4426950408889634f); sum += e[i]; }
        const float inv = 1.0f / sum;
        int* eo = eidx + (size_t)t * 128 + h * 16; float* go = gwt + (size_t)t * 128 + h * 16;
        LDS_WAIT();
#pragma unroll
        for (int i = 0; i < 16; ++i) {
            const unsigned ab = 255u - (c[0][i] & 255u);
            const int i1 = ib[ab >> 4], i2 = ib[16 + (ab & 15u)];
            if (wr) { eo[i] = i1 * 128 + i2; go[i] = e[i] * inv; }
        }
        LDS_WAIT();
    }
}

constexpr float PU_SCALE = 64.f, PV_SCALE = 16.f, Y_AK = 4.f;
typedef _Float16 h2v __attribute__((ext_vector_type(2)));
constexpr int G_NR = 64, G_SH = 8;
typedef unsigned u2v __attribute__((ext_vector_type(2)));
__device__ __forceinline__ float reduce4(float p0, float p1, float p2, float p3) {
    const u2v r01 = __builtin_amdgcn_permlane32_swap(__builtin_bit_cast(unsigned, p0), __builtin_bit_cast(unsigned, p1), false, false);
    const u2v r23 = __builtin_amdgcn_permlane32_swap(__builtin_bit_cast(unsigned, p2), __builtin_bit_cast(unsigned, p3), false, false);
    const unsigned a0 = r01.x, a1 = r01.y, b0 = r23.x, b1 = r23.y;
    const float s01 = __builtin_bit_cast(float, a0) + __builtin_bit_cast(float, a1), s23 = __builtin_bit_cast(float, b0) + __builtin_bit_cast(float, b1);
    const u2v q = __builtin_amdgcn_permlane16_swap(__builtin_bit_cast(unsigned, s01), __builtin_bit_cast(unsigned, s23), false, false);
    const unsigned q0 = q.x, q1 = q.y;
    return row16_sum(__builtin_bit_cast(float, q0) + __builtin_bit_cast(float, q1));
}
__device__ __forceinline__ void gsort2(unsigned& ka0, unsigned& kb0, unsigned& ka1, unsigned& kb1, int lane) {
#pragma unroll
    for (int k = 2; k <= 128; k <<= 1)
#pragma unroll
        for (int j = k >> 1; j > 0; j >>= 1)
#pragma unroll
            for (int s = 0; s < 2; ++s) {
                unsigned& ka = s ? ka1 : ka0; unsigned& kb = s ? kb1 : kb0;
                if (j == 64) { const unsigned lo = ka < kb ? ka : kb, hi = ka < kb ? kb : ka; ka = lo; kb = hi; }
                else {
                    const unsigned pa = (unsigned)__builtin_amdgcn_ds_bpermute((lane ^ j) << 2, (int)ka), pb = (unsigned)__builtin_amdgcn_ds_bpermute((lane ^ j) << 2, (int)kb);
                    const bool lower = (lane & j) == 0;
                    const bool upa = (k >= 128) ? true : ((lane & k) == 0);
                    const bool upb = (k >= 128) ? true : ((k == 64) ? false : ((lane & k) == 0));
                    const unsigned mna = ka < pa ? ka : pa, mxa = ka < pa ? pa : ka;
                    const unsigned mnb = kb < pb ? kb : pb, mxb = kb < pb ? pb : kb;
                    ka = (upa == lower) ? mna : mxa; kb = (upb == lower) ? mnb : mxb;
                }
            }
}
__device__ __forceinline__ void gsort4(unsigned (&ka_)[4], unsigned (&kb_)[4], int lane) {
#pragma unroll
    for (int k = 2; k <= 128; k <<= 1)
#pragma unroll
        for (int j = k >> 1; j > 0; j >>= 1) {
            if (j == 64) {
#pragma unroll
                for (int s = 0; s < 4; ++s) { const unsigned lo = ka_[s] < kb_[s] ? ka_[s] : kb_[s], hi = ka_[s] < kb_[s] ? kb_[s] : ka_[s]; ka_[s] = lo; kb_[s] = hi; }
            } else {
                unsigned pa[4], pb[4];
#pragma unroll
                for (int s = 0; s < 4; ++s) { pa[s] = (unsigned)__builtin_amdgcn_ds_bpermute((lane ^ j) << 2, (int)ka_[s]); pb[s] = (unsigned)__builtin_amdgcn_ds_bpermute((lane ^ j) << 2, (int)kb_[s]); }
                const bool lower = (lane & j) == 0;
                const bool upa = (k >= 128) ? true : ((lane & k) == 0);
                const bool upb = (k >= 128) ? true : ((k == 64) ? false : ((lane & k) == 0));
#pragma unroll
                for (int s = 0; s < 4; ++s) {
                    const unsigned mna = ka_[s] < pa[s] ? ka_[s] : pa[s], mxa = ka_[s] < pa[s] ? pa[s] : ka_[s];
                    const unsigned mnb = kb_[s] < pb[s] ? kb_[s] : pb[s], mxb = kb_[s] < pb[s] ? pb[s] : kb_[s];
                    ka_[s] = (upa == lower) ? mna : mxa; kb_[s] = (upb == lower) ? mnb : mxb;
                }
            }
        }
}
constexpr int GNS = 4;
__device__ __forceinline__ void phase_gather(Frame& F, int layer, bf16* hb, bool dry = false) {
    unsigned char* ws = F.ws;
    const int* eidx = (const int*)(ws + WS_EIDX); const float* gwt = (const float*)(ws + WS_GW);
    const float* g2 = inp(IN_LN2G) + layer * D; const float* b2 = inp(IN_LN2B) + layer * D;
    const int tpb = (T + F.G - 1) / F.G, t0 = F.bx * tpb, cnt = (T - t0) < tpb ? (T - t0 > 0 ? T - t0 : 0) : tpb;
    const int lane = F.lane;
    const __amdgpu_buffer_rsrc_t srdU = __builtin_amdgcn_make_buffer_rsrc((void*)(ws + WS_PU + (size_t)layer * NEXP * D), (short)0, NEXP * D, 0x00020000);
    const __amdgpu_buffer_rsrc_t srdV = __builtin_amdgcn_make_buffer_rsrc((void*)(ws + WS_PV + (size_t)layer * NEXP * D), (short)0, NEXP * D, 0x00020000);
    const unsigned l16 = (unsigned)lane * 16u;
    const bool dg = (lane >> 4) == ((lane & 15) >> 2);
    const int ridx = (int)(reduce4(1.f / 64.f, 2.f / 64.f, 3.f / 64.f, 4.f / 64.f) + 0.5f) - 1;
    const int pos0 = __builtin_ctzll(__ballot(ridx == 0)), pos1 = __builtin_ctzll(__ballot(ridx == 1)), pos2 = __builtin_ctzll(__ballot(ridx == 2)), pos3 = __builtin_ctzll(__ballot(ridx == 3));
    const int npass = ((cnt + NWAVES - 1) / NWAVES + GNS - 1) / GNS;
#pragma unroll 1
    for (int pass = 0; pass < npass; ++pass) {
        long xq[GNS][2]; h2v yh[GNS][8];
        unsigned ka[GNS], kb[GNS]; float ga[GNS], gb[GNS]; int tk[GNS];
        int nv = 0;
#pragma unroll
        for (int s = 0; s < GNS; ++s) {
            const int tt = F.wave + NWAVES * (GNS * pass + s);
            const bool ok = tt < cnt; const int t = ok ? t0 + tt : t0;
            tk[s] = ok ? t : -1; nv += ok ? 1 : 0;
            {
                const v4u x0 = *(const v4u*)(hb + (size_t)t * D + lane * 16), x1 = *(const v4u*)(hb + (size_t)t * D + lane * 16 + 8);
                int q0 = __builtin_amdgcn_cvt_pk_fp8_f32(bflo(x0.x), bfhi(x0.x), 0, false); q0 = __builtin_amdgcn_cvt_pk_fp8_f32(bflo(x0.y), bfhi(x0.y), q0, true);
                int q1 = __builtin_amdgcn_cvt_pk_fp8_f32(bflo(x0.z), bfhi(x0.z), 0, false); q1 = __builtin_amdgcn_cvt_pk_fp8_f32(bflo(x0.w), bfhi(x0.w), q1, true);
                int q2 = __builtin_amdgcn_cvt_pk_fp8_f32(bflo(x1.x), bfhi(x1.x), 0, false); q2 = __builtin_amdgcn_cvt_pk_fp8_f32(bflo(x1.y), bfhi(x1.y), q2, true);
                int q3 = __builtin_amdgcn_cvt_pk_fp8_f32(bflo(x1.z), bfhi(x1.z), 0, false); q3 = __builtin_amdgcn_cvt_pk_fp8_f32(bflo(x1.w), bfhi(x1.w), q3, true);
                xq[s][0] = (long)(((unsigned long long)(unsigned)q1 << 32) | (unsigned)q0); xq[s][1] = (long)(((unsigned long long)(unsigned)q3 << 32) | (unsigned)q2);
#pragma unroll
                for (int p = 0; p < 8; ++p) yh[s][p] = (h2v){(_Float16)0.f, (_Float16)0.f};
            }
            ka[s] = ((unsigned)eidx[(size_t)t * 128 + lane] << 7) | (unsigned)lane;
            kb[s] = ((unsigned)eidx[(size_t)t * 128 + 64 + lane] << 7) | (unsigned)(64 + lane);
            ga[s] = gwt[(size_t)t * 128 + lane]; gb[s] = gwt[(size_t)t * 128 + 64 + lane];
        }
        nv = __builtin_amdgcn_readfirstlane(nv);
        if (nv > 2) gsort4(ka, kb, lane); else if (nv > 0) gsort2(ka[0], kb[0], ka[1], kb[1], lane);
#pragma unroll
        for (int z = 0; z < GNS; ++z) {
            if (z < nv) {
                const int ja = (int)(ka[z] & 127u), jb = (int)(kb[z] & 127u);
                const float a0 = bperm(ja & 63, ga[z]), a1 = bperm(ja & 63, gb[z]), b0 = bperm(jb & 63, ga[z]), b1 = bperm(jb & 63, gb[z]);
                ga[z] = (ja & 64) ? a1 : a0; gb[z] = (jb & 64) ? b1 : b0;
            }
        }
        v4u uA[4], vA[4], uB[4], vB[4];
#define G_FILL4(s, X, st) do { _Pragma("unroll") for (int i_ = 0; i_ < 4; ++i_) { \
            const int e_ = __builtin_amdgcn_readlane((int)ka[s], 4 * (st) + i_) >> 7; \
            u##X[i_] = __builtin_amdgcn_raw_buffer_load_b128(srdU, (int)l16, e_ * D, 0); v##X[i_] = __builtin_amdgcn_raw_buffer_load_b128(srdV, (int)l16, e_ * D, 0); } } while (0)
#define G_CVH(W, HI) __builtin_bit_cast(h2v, __builtin_amdgcn_cvt_scalef32_pk_f16_fp8((W), 1.0f, (HI)))
#define G_STEP4(s, X, st) do { float pt_[4]; f32x4 ac_[4]; \
              \
            _Pragma("unroll") for (int i_ = 0; i_ < 4; ++i_) { \
                ac_[i_] = __builtin_amdgcn_mfma_f32_16x16x32_fp8_fp8((long)(((unsigned long long)u##X[i_][1] << 32) | u##X[i_][0]), xq[s][0], (f32x4){0.f, 0.f, 0.f, 0.f}, 0, 0, 0); \
                ac_[i_] = __builtin_amdgcn_mfma_f32_16x16x32_fp8_fp8((long)(((unsigned long long)u##X[i_][3] << 32) | u##X[i_][2]), xq[s][1], ac_[i_], 0, 0, 0); } \
            const float gv_ = bperm(4 * (st) + ridx, ga[s]);               \
            _Pragma("unroll") for (int i_ = 0; i_ < 4; ++i_) { \
                const float dv_ = (lane & 2) ? ((lane & 1) ? ac_[i_][3] : ac_[i_][2]) : ((lane & 1) ? ac_[i_][1] : ac_[i_][0]);     \
                pt_[i_] = dg ? dv_ : 0.f; } \
            const float tw_ = reduce4(pt_[0], pt_[1], pt_[2], pt_[3]);     \
            const _Float16 ah_ = (_Float16)(gelu_tanh(tw_ * (1.f / PU_SCALE)) * gv_ * Y_AK);     \
            const h2v ap_ = {ah_, ah_}; const int av_ = __builtin_bit_cast(int, ap_); \
            _Pragma("unroll") for (int i_ = 0; i_ < 4; ++i_) { \
                const h2v a2_ = __builtin_bit_cast(h2v, __builtin_amdgcn_readlane(av_, i_ == 0 ? pos0 : i_ == 1 ? pos1 : i_ == 2 ? pos2 : pos3)); \
                _Pragma("unroll") for (int w_ = 0; w_ < 4; ++w_) { \
                    yh[s][2 * w_] = __builtin_elementwise_fma(G_CVH(v##X[i_][w_], false), a2_, yh[s][2 * w_]); \
                    yh[s][2 * w_ + 1] = __builtin_elementwise_fma(G_CVH(v##X[i_][w_], true), a2_, yh[s][2 * w_ + 1]); } } } while (0)
#define G_SYNC(it) do { if ((it) && !((it) & 3)) __syncthreads(); } while (0)
#pragma unroll 1
        for (int half = 0; half < 2; ++half) {
            __syncthreads();
            if (nv == 4) {
                G_FILL4(0, A, 0);
#pragma unroll 1
                for (int it = 0; it < 16; ++it) {
                    G_SYNC(it);
                    G_FILL4(1, B, it); G_STEP4(0, A, it);
                    G_FILL4(2, A, it); G_STEP4(1, B, it);
                    G_FILL4(3, B, it); G_STEP4(2, A, it);
                    if (it < 15) G_FILL4(0, A, it + 1);
                    G_STEP4(3, B, it);
                }
            } else if (nv == 1) {
                G_FILL4(0, A, 0);
#pragma unroll 1
                for (int it = 0; it < 16; it += 2) {
                    G_SYNC(it);
                    G_FILL4(0, B, it + 1); G_STEP4(0, A, it);
                    if (it < 14) G_FILL4(0, A, it + 2);
                    G_STEP4(0, B, it + 1);
                }
            } else {
#define G_SLOW(s) if ((s) < nv) { _Pragma("unroll 1") for (int it = 0; it < 16; ++it) { G_FILL4(s, A, it); G_STEP4(s, A, it); } }
                G_SLOW(0) G_SLOW(1) G_SLOW(2) G_SLOW(3)
#undef G_SLOW
                __syncthreads(); __syncthreads(); __syncthreads();
            }
#pragma unroll
            for (int s = 0; s < GNS; ++s) { ka[s] = kb[s]; ga[s] = gb[s]; }
        }
#undef G_FILL4
#undef G_STEP4
#undef G_CVH
#undef G_SYNC
        f32x4 g2q[4], b2q[4];
#pragma unroll
        for (int c = 0; c < 4; ++c) { g2q[c] = *(const f32x4*)(g2 + lane * 16 + 4 * c); b2q[c] = *(const f32x4*)(b2 + lane * 16 + 4 * c); }
#pragma unroll
        for (int s = 0; s < GNS; ++s) {
            float sm = 0.f; f32x2 y[8];
            { const int tsafe = tk[s] >= 0 ? tk[s] : t0;
              const v4u x0 = *(const v4u*)(hb + (size_t)tsafe * D + lane * 16), x1 = *(const v4u*)(hb + (size_t)tsafe * D + lane * 16 + 8);
              const f32x2 xr[8] = {(f32x2){bflo(x0.x), bfhi(x0.x)}, (f32x2){bflo(x0.y), bfhi(x0.y)}, (f32x2){bflo(x0.z), bfhi(x0.z)}, (f32x2){bflo(x0.w), bfhi(x0.w)},
                                   (f32x2){bflo(x1.x), bfhi(x1.x)}, (f32x2){bflo(x1.y), bfhi(x1.y)}, (f32x2){bflo(x1.z), bfhi(x1.z)}, (f32x2){bflo(x1.w), bfhi(x1.w)}};
#pragma unroll
              for (int p = 0; p < 8; ++p) { y[p] = xr[p] * ALPHA + (f32x2){(float)yh[s][p].x, (float)yh[s][p].y} * (1.f / (PV_SCALE * Y_AK)); sm += y[p].x + y[p].y; } }
            const float mean = wave_sum(sm) * (1.f / D);
            float s2 = 0.f;
#pragma unroll
            for (int p = 0; p < 8; ++p) { y[p] = y[p] - mean; s2 += y[p].x * y[p].x + y[p].y * y[p].y; }
            const float rstd = __builtin_amdgcn_rsqf(wave_sum(s2) * (1.f / D) + LN_EPS);
            if (dry) asm volatile("" :: "v"(rstd));
            if (tk[s] >= 0 && !dry) {
                const size_t ro = (size_t)tk[s] * D + lane * 16;
                unsigned wb[8];
#pragma unroll
                for (int c = 0; c < 4; ++c) {
                    const f32x4 ga = g2q[c], ba = b2q[c];
                    f32x4 o;
                    o[0] = y[2 * c].x * rstd * ga[0] + ba[0]; o[1] = y[2 * c].y * rstd * ga[1] + ba[1];
                    o[2] = y[2 * c + 1].x * rstd * ga[2] + ba[2]; o[3] = y[2 * c + 1].y * rstd * ga[3] + ba[3];
                    wb[2 * c] = pk2(o[0], o[1]); wb[2 * c + 1] = pk2(o[2], o[3]);
                }
                *(v4u*)(hb + ro) = (v4u){wb[0], wb[1], wb[2], wb[3]}; *(v4u*)(hb + ro + 8) = (v4u){wb[4], wb[5], wb[6], wb[7]};
            }
        }
    }
}

__device__ __forceinline__ void phase_attn(Frame& F, int jl  ) {
    unsigned char* ws = F.ws;
    const bf16* qb = (const bf16*)(ws + WS_QB); const bf16* kvb = (const bf16*)(ws + WS_KVB); bf16* att = (bf16*)(ws + WS_ATT);
    const float* sinks = inp(IN_SINK) + jl * 16;
    constexpr int KS = 144, VSB = 192;
    LAS unsigned char* Kl = F.lds; LAS unsigned char* Vl = F.lds + 256 * KS;
    const int lane = F.lane, ql = lane & 31, hh2 = lane >> 5;
    for (int unit = F.bx; unit < 256; unit += F.G) {
        const int b = unit >> 7, n = (unit >> 1) & 63, kvh = unit & 1;
        const int tokb = b * 8192 + 128 * n;
#pragma unroll
        for (int i = 0; i < 4; ++i) {
            const int id = F.tid + 512 * i, row = id >> 3, ch = id & 7;
            const int tok = (row < 128) ? ((n > 0) ? tokb - 128 + row : tokb + row) : tokb + row - 128;
            const v4u kk = *(const v4u*)(kvb + (size_t)tok * 256 + kvh * 64 + ch * 8);
            const v4u vv = *(const v4u*)(kvb + (size_t)tok * 256 + 128 + kvh * 64 + ch * 8);
            *(LAS v4u*)(Kl + row * KS + ch * 16) = kk; *(LAS v4u*)(Vl + row * VSB + ch * 16) = vv;
        }
        __syncthreads();
        const int hd = kvh * 8 + F.wave;
        const float slope = fexp2(-0.5f * (float)(hd + 1)), sink = sinks[hd];
        const unsigned vlane = (unsigned)(uintptr_t)Vl + (unsigned)((4 * (lane >> 5) + ((lane & 15) >> 2)) * VSB + (16 * ((lane >> 4) & 1) + 4 * (lane & 3)) * 2);
        const GAS bf16* qg = (const GAS bf16*)qb; GAS bf16* ag = (GAS bf16*)att;
        bf16x8 qf[4];
#pragma unroll
        for (int s = 0; s < 4; ++s) qf[s] = *(const GAS bf16x8*)(qg + (size_t)(tokb + ql) * D + hd * 64 + 16 * s + 8 * hh2);
#pragma unroll 1
        for (int qs = 0; qs < 4; ++qs) {
            const int tq = tokb + 32 * qs + ql;
            bf16x8 qn[4];
            { const int tqn = tokb + 32 * (qs < 3 ? qs + 1 : qs) + ql;
#pragma unroll
              for (int s = 0; s < 4; ++s) qn[s] = *(const GAS bf16x8*)(qg + (size_t)tqn * D + hd * 64 + 16 * s + 8 * hh2); }
            f32x16 st[5];
#pragma unroll
            for (int t5 = 0; t5 < 5; ++t5) {
                f32x16 acc;
#pragma unroll
                for (int r = 0; r < 16; ++r) acc[r] = 0.f;
                const int kt = qs + t5;
#pragma unroll
                for (int s = 0; s < 4; ++s) {
                    const bf16x8 kf = *(const LAS bf16x8*)(Kl + (32 * kt + ql) * KS + (16 * s + 8 * hh2) * 2);
                    acc = __builtin_amdgcn_mfma_f32_32x32x16_bf16(kf, qf[s], acc, 0, 0, 0);
                }
                st[t5] = acc;
            }
            const int iq = 32 * qs + ql;
            float m = sink;
#pragma unroll
            for (int t5 = 0; t5 < 5; ++t5)
#pragma unroll
                for (int r = 0; r < 16; ++r) {
                    const int j = 32 * (qs + t5) + (r & 3) + 8 * (r >> 2) + 4 * hh2;
                    const int dist = iq + 128 - j;
                    const bool valid = (dist >= 0) && (dist < 128) && ((n > 0) || (j >= 128));
                    const float sv = valid ? st[t5][r] * 0.125f - slope * (float)dist : -INFINITY;
                    st[t5][r] = sv; m = fmaxf(m, sv);
                }
            m = fmaxf(m, bperm(lane ^ 32, m));
            float l = 0.f;
            v4u pw[5][2];
#pragma unroll
            for (int t5 = 0; t5 < 5; ++t5)
#pragma unroll
                for (int s2 = 0; s2 < 2; ++s2) {
                    float p[8];
#pragma unroll
                    for (int e = 0; e < 8; ++e) { p[e] = fexp2((st[t5][8 * s2 + e] - m) * 1.4426950408889634f); l += p[e]; }
                    pw[t5][s2] = (v4u){pk2(p[0], p[1]), pk2(p[2], p[3]), pk2(p[4], p[5]), pk2(p[6], p[7])};
                }
            l += bperm(lane ^ 32, l);
            l += fexp2((sink - m) * 1.4426950408889634f);
#if defined(DBG_NOATT)
            const float inv = 0.f / l;
#else
            const float inv = 1.0f / l;
#endif
            f32x16 o0, o1;
#pragma unroll
            for (int r = 0; r < 16; ++r) { o0[r] = 0.f; o1[r] = 0.f; }
#pragma unroll
            for (int t5 = 0; t5 < 5; ++t5) {
                const int kt = qs + t5;
#pragma unroll
                for (int s2 = 0; s2 < 2; ++s2) {
                    const bf16x8 pf = __builtin_bit_cast(bf16x8, pw[t5][s2]);
                    s16x4 a0, a1, c0, c1;
                    const unsigned va = vlane + (unsigned)((32 * kt + 16 * s2) * VSB);
                    asm volatile("ds_read_b64_tr_b16 %0, %4\n\tds_read_b64_tr_b16 %1, %4 offset:1536\n\tds_read_b64_tr_b16 %2, %4 offset:64\n\tds_read_b64_tr_b16 %3, %4 offset:1600\n\ts_waitcnt lgkmcnt(0)"
                                 : "=&v"(a0), "=&v"(a1), "=&v"(c0), "=&v"(c1) : "v"(va) : "memory");
                    const bf16x8 vf0 = (bf16x8){a0[0], a0[1], a0[2], a0[3], a1[0], a1[1], a1[2], a1[3]};
                    const bf16x8 vf1 = (bf16x8){c0[0], c0[1], c0[2], c0[3], c1[0], c1[1], c1[2], c1[3]};
                    o0 = __builtin_amdgcn_mfma_f32_32x32x16_bf16(vf0, pf, o0, 0, 0, 0);
                    o1 = __builtin_amdgcn_mfma_f32_32x32x16_bf16(vf1, pf, o1, 0, 0, 0);
                }
            }
            GAS bf16* op = ag + (size_t)tq * D + hd * 64 + 4 * hh2;
#pragma unroll
            for (int g4 = 0; g4 < 4; ++g4) {
                v2u w; w.x = pk2(o0[4 * g4 + 0] * inv, o0[4 * g4 + 1] * inv); w.y = pk2(o0[4 * g4 + 2] * inv, o0[4 * g4 + 3] * inv);
                *(GAS v2u*)(op + 8 * g4) = w;
                v2u x; x.x = pk2(o1[4 * g4 + 0] * inv, o1[4 * g4 + 1] * inv); x.y = pk2(o1[4 * g4 + 2] * inv, o1[4 * g4 + 3] * inv);
                *(GAS v2u*)(op + 32 + 8 * g4) = x;
            }
#pragma unroll
            for (int s = 0; s < 4; ++s) qf[s] = qn[s];
        }
        __syncthreads();
    }
    {
        const float* ck = inp(IN_CK); const float* cv = inp(IN_CV);
        constexpr int KSS = 68;
        LAS float* Ksm = (LAS float*)F.lds; LAS float* Vsm = (LAS float*)(F.lds + 136 * KSS * 4);
        for (int su = F.bx; su < 256; su += F.G) {
            const int db = su >> 1, kvh = su & 1;
            int tid_ = F.tid; asm volatile("" : "+v"(tid_));
            const int hd = kvh * 8 + F.wave;
            const float slope = fexp2(-0.5f * (float)(hd + 1)), sink = sinks[hd];
            LAS unsigned char* Ql = F.lds + 73728 + F.wave * 1024;
            const v4u qrow = *(const v4u*)(qb + (size_t)(TP + db * 8 + (lane >> 3)) * D + hd * 64 + (lane & 7) * 8);
            {
                f32x4 kq[4], vq[4]; v2u kw = {0u, 0u}, vw = {0u, 0u};
#pragma unroll
                for (int i = 0; i < 4; ++i) { const int id = tid_ + 512 * i, j = id >> 4, c4 = (id & 15) * 4;
                    kq[i] = *(const f32x4*)(ck + ((size_t)(db * 128 + j) * 2 + kvh) * 64 + c4); vq[i] = *(const f32x4*)(cv + ((size_t)(db * 128 + j) * 2 + kvh) * 64 + c4); }
                if (tid_ < 128) { const int j = 128 + (tid_ >> 4), c4 = (tid_ & 15) * 4;
                    kw = *(const v2u*)(kvb + (size_t)(TP + db * 8 + j - 128) * 256 + kvh * 64 + c4); vw = *(const v2u*)(kvb + (size_t)(TP + db * 8 + j - 128) * 256 + 128 + kvh * 64 + c4); }
#pragma unroll
                for (int i = 0; i < 4; ++i) { const int id = tid_ + 512 * i, j = id >> 4, c4 = (id & 15) * 4;
                    *(LAS f32x4*)(Ksm + j * KSS + c4) = kq[i]; *(LAS f32x4*)(Vsm + j * 64 + c4) = vq[i]; }
                if (tid_ < 128) { const int j = 128 + (tid_ >> 4), c4 = (tid_ & 15) * 4;
                    *(LAS f32x4*)(Ksm + j * KSS + c4) = (f32x4){bflo(kw.x), bfhi(kw.x), bflo(kw.y), bfhi(kw.y)}; *(LAS f32x4*)(Vsm + j * 64 + c4) = (f32x4){bflo(vw.x), bfhi(vw.x), bflo(vw.y), bfhi(vw.y)}; }
                *(LAS v4u*)(Ql + lane * 16) = qrow;
            }
            __syncthreads();
#pragma unroll 2
            for (int l = 0; l < 8; ++l) {
                const int tq = TP + db * 8 + l;
                v4u qv[8];
#pragma unroll
                for (int i = 0; i < 8; ++i) qv[i] = *(const LAS v4u*)(Ql + l * 128 + i * 16);
                float sc[3];
#pragma unroll
                for (int ps = 0; ps < 3; ++ps) {
                    const int jj = lane + 64 * ps, jr = jj < 136 ? jj : 135;
                    const LAS float* kr = Ksm + jr * KSS;
                    float dot = 0.f;
#pragma unroll
                    for (int i = 0; i < 8; ++i) {
                        const f32x4 k0 = *(const LAS f32x4*)(kr + i * 8), k1 = *(const LAS f32x4*)(kr + i * 8 + 4);
                        dot += bflo(qv[i].x) * k0[0] + bfhi(qv[i].x) * k0[1] + bflo(qv[i].y) * k0[2] + bfhi(qv[i].y) * k0[3]
                             + bflo(qv[i].z) * k1[0] + bfhi(qv[i].z) * k1[1] + bflo(qv[i].w) * k1[2] + bfhi(qv[i].w) * k1[3];
                    }
                    const int dist = l + 128 - jj;
                    const bool valid = (jj < 136) && (dist >= 0) && (dist < 128);
                    sc[ps] = valid ? dot * 0.125f - slope * (float)dist : -INFINITY;
                }
                const float m = fmaxf(wave_max(fmaxf(fmaxf(sc[0], sc[1]), sc[2])), sink);
                const float p0 = fexp2((sc[0] - m) * 1.4426950408889634f), p1 = fexp2((sc[1] - m) * 1.4426950408889634f), p2 = fexp2((sc[2] - m) * 1.4426950408889634f);
                const float lsum = wave_sum(p0 + p1 + p2) + fexp2((sink - m) * 1.4426950408889634f);
                float oa[4] = {0.f, 0.f, 0.f, 0.f};
                const int p0i = __builtin_bit_cast(int, p0), p1i = __builtin_bit_cast(int, p1), p2i = __builtin_bit_cast(int, p2);
#pragma unroll 4
                for (int jb = 0; jb < 64; jb += 4) {
#pragma unroll
                    for (int u = 0; u < 4; ++u) {
                        oa[u] += __builtin_bit_cast(float, __builtin_amdgcn_readlane(p0i, jb + u)) * Vsm[(jb + u) * 64 + lane];
                        oa[u] += __builtin_bit_cast(float, __builtin_amdgcn_readlane(p1i, jb + u)) * Vsm[(jb + u + 64) * 64 + lane];
                    }
                }
#pragma unroll
                for (int jj = 0; jj < 8; ++jj) oa[jj & 3] += __builtin_bit_cast(float, __builtin_amdgcn_readlane(p2i, jj)) * Vsm[(128 + jj) * 64 + lane];
                const float o = (oa[0] + oa[1]) + (oa[2] + oa[3]);
#if defined(DBG_NOATT)
                att[(size_t)tq * D + hd * 64 + lane] = (bf16)f2bf(0.f * o / lsum);
#else
                att[(size_t)tq * D + hd * 64 + lane] = (bf16)f2bf(o / lsum);
#endif
            }
            __syncthreads();
        }
    }
}

#ifndef PH_MASK
#define PH_MASK 0xFFFF
#endif
#define PHM(b) ((PH_MASK >> (b)) & 1)
#ifndef DBG_REP
#define DBG_REP 0
#endif

struct Args { const float* in[29]; float* out; unsigned char* ws; int ph_lo, ph_hi; };
__global__ void __launch_bounds__(NWAVES * 64, 2) yoco_fwd(Args args) {
    extern __shared__ __attribute__((aligned(16))) unsigned char lds_raw[];
    Frame F;
    F.lds = (LAS unsigned char*)lds_raw;
    F.MISC = (volatile LAS unsigned*)(F.lds + MISC_OFF);
    const int wave0 = __builtin_amdgcn_readfirstlane(threadIdx.x >> 6);
    F.tid = threadIdx.x; F.lane = F.tid & 63; F.wave = wave0;
    F.G = gridDim.x;
    F.out = args.out; F.ws = args.ws; F.ctl = (gu32*)(args.ws + WS_CTL);
    GAS unsigned char* wsg = (GAS unsigned char*)args.ws;
    unsigned char* ws = args.ws;
    for (int u = F.tid; u < (LDS_BYTES - LDSCTL_OFF) / 4; u += NWAVES * 64) ((LAS unsigned*)(F.lds + LDSCTL_OFF))[u] = 0u;
    __syncthreads();
    XcdBarrier bar; bar.bar = (unsigned*)(F.ctl + CW_BAR); bar.x = 0; bar.st = nullptr;
    if (MK_N_LAUNCHES == 1) bar = xcd_barrier_post((unsigned*)(F.ctl + CW_BAR), F.MISC + 8);

    for (int it = 2 * args.ph_lo; it < 2 * args.ph_hi; ++it) {
        const int ph = it >> 1;
        int cls = (ph < 2) ? ph + 8 : ((ph - 2) & 7);
        if (cls == 1 && ph >= 18) cls = 10;
        const bool twice = ((DBG_REP >> cls) & 1) != 0;
        if (!(it & 1) && !twice) continue;
        const bool dry = !(it & 1);
#define FRESH() do { int l_; asm volatile("v_mbcnt_lo_u32_b32 %0, -1, 0\n\tv_mbcnt_hi_u32_b32 %0, -1, %0" : "=v"(l_)); F.lane = l_; F.wave = wave0; F.tid = wave0 * 64 + l_; } while (0)
        unsigned char* wsf = args.ws; asm volatile("" : "+s"(wsf));
        asm volatile("" : "+s"(wsg)); ws = (unsigned char*)wsg; F.ws = ws;
        int bx = blockIdx.x, gx = gridDim.x; asm volatile("" : "+s"(bx), "+s"(gx)); F.G = gx; F.bx = bx;
        if (ph == 0) {
            FRESH(); if (PHM(0)) phase_prologue(F);
        } else if (ph == 1) {
            FRESH();
            if (PHM(2)) {
                pg8::Gemm g2{(const bf16*)(ws + WS_PBF), (const bf16*)(ws + WS_PLE), 4 * T, 1024, 256};
                pg8::StaticOrder S2; S2.init(4 * T, 1024, F.G, (bx + 192) % F.G, T / 256);
                EpiBf E2{(bf16*)(ws + WS_PP), 1024};
                pg8::gemm_phase<EpiBf, pg8::StaticOrder, true, true>(F.lds, g2, S2, E2, F.tid);
            }
        } else {
            const int qq = ph - 2, layer = qq >> 3, sub = qq & 7;
            bf16* HBc = (bf16*)(ws + ((layer & 1) ? WS_HB2 : WS_HB));
            bf16* HBn = (bf16*)(ws + ((layer & 1) ? WS_HB : WS_HB2));
            if (sub == 0) {
                FRESH();
                if (!PHM(1)) {} else if (layer < 2) {
                    pg8::Gemm g{HBc, (const bf16*)(ws + WS_WIN) + (size_t)layer * 4096 * 1024, T, 4096, 1024};
                    pg8::StaticOrder S; S.init(T, 4096, F.G, bx);
                    EpiZ E{(bf16*)(ws + WS_Z), inp(IN_BIN) + layer * 4096, (float*)(ws + WS_STATS)};
                    pg8::gemm_phase<EpiZ, pg8::StaticOrder, true, true>(F.lds, g, S, E, F.tid);
                    FRESH(); table_filler(F, layer, 0, (T / 256) * 16);
                } else if (PHM(3)) {
                    const bool first = (layer == 2);
                    pg8::Gemm g{HBc, (const bf16*)(ws + (first ? WS_WQKV : WS_WQ1)), first ? T : TP, first ? 1280 : 1024, 1024};
                    pg8::StaticOrder S; S.init(first ? T : TP, first ? 1280 : 1024, F.G, bx);
                    EpiQKV E{(bf16*)(ws + WS_QB), (bf16*)(ws + WS_KVB), F.out};
                    pg8::gemm_phase<EpiQKV, pg8::StaticOrder, true, true>(F.lds, g, S, E, F.tid);
                    FRESH();
                    if (!first) sgemm64(F, g.A, g.Bt, TP, TS / 64, 16, g.K, E);
                    if (first) table_filler(F, layer, 0, (T / 256) * 5);
                }
            } else if (sub == 1) {
                FRESH();
                if (layer < 2) { if (PHM(4)) phase_spatial(F, layer); } else { F.ws = wsf; if (PHM(5)) phase_attn(F, layer - 2); }
            } else if (sub == 2 && PHM(6)) {
                FRESH();
                const bool isa = layer < 2;
                pg8::Gemm g{isa ? (const bf16*)(ws + WS_GATED) : (const bf16*)(ws + WS_ATT),
                            isa ? (const bf16*)(ws + WS_WOUT) + (size_t)layer * 1024 * 2048 : (const bf16*)(ws + WS_WO) + (size_t)(layer - 2) * 1024 * 1024, TP, 1024, isa ? 2048 : 1024};
                pg8::StaticOrder S; S.init(TP, 1024, F.G, bx);
                EpiPre E{(bf16*)(ws + WS_PRE), HBc, isa ? inp(IN_BOUT) + layer * 1024 : nullptr};
                pg8::gemm_phase<EpiPre, pg8::StaticOrder, true, true>(F.lds, g, S, E, F.tid);
                FRESH(); sgemm64(F, g.A, g.Bt, TP, TS / 64, 16, g.K, E);
            } else if (sub == 3 && PHM(7)) {
                FRESH();
                phase_ln1(F, layer, HBc);
            } else if (sub == 4 && PHM(8)) {
                FRESH();
                pg8::Gemm g{(const bf16*)(ws + WS_WQK) + (size_t)layer * 2048 * 1024, HBc, 2048, T, 1024};
                pg8::StaticOrder S; S.init(2048, T, F.G, bx);
                EpiF32 E{(unsigned*)(ws + WS_SC), T};
                pg8::gemm_phase<EpiF32, pg8::StaticOrder, true, true>(F.lds, g, S, E, F.tid);
                FRESH(); table_filler(F, layer, 1, 8 * (T / 256));
                if (layer == 3) table_filler(F, layer, 0, 8 * (T / 256));
            } else if (sub == 5 && PHM(9)) {
                FRESH();
                phase_topk(F);
            } else if (sub == 6 && PHM(10)) {
                FRESH();
                phase_gather(F, layer, HBc, dry);
            } else if (sub == 7 && PHM(11)) {
                FRESH();
                pg8::Gemm g{HBc, (const bf16*)(ws + WS_GATE) + (size_t)layer * 1024 * 1024, TP, 1024, 1024};
                pg8::StaticOrder S; S.init(TP, 1024, F.G, bx);
                EpiGate E{HBc, HBn, (const bf16*)(ws + WS_PP) + (size_t)layer * T * 1024, inp(IN_GB) + layer * 1024, layer == 3 ? F.out : nullptr};
                pg8::gemm_phase<EpiGate, pg8::StaticOrder, true, true>(F.lds, g, S, E, F.tid);
                FRESH(); sgemm64(F, g.A, g.Bt, TP, TS / 64, 16, g.K, E);
            }
        }
        const bool same_wg_seam = (MK_N_LAUNCHES == 1) && (ph >= 2) && (((ph - 2) & 7) == 5);
        if (ph == 1 && MK_N_LAUNCHES == 1) { }
        else if (same_wg_seam) { asm volatile("s_waitcnt vmcnt(0)" ::: "memory"); __syncthreads(); }
        else if (it + 1 < 2 * args.ph_hi) { int l_; asm volatile("v_mbcnt_lo_u32_b32 %0, -1, 0\n\tv_mbcnt_hi_u32_b32 %0, -1, %0" : "=v"(l_)); xcd_barrier(bar, wave0 * 64 + l_); if ((DBG_REP >> 11) & 1) xcd_barrier(bar, wave0 * 64 + l_); }
    }
}

extern "C" void kernel_launch(void* const* d_in, const int* in_sizes, int n_in, void* d_out, int out_size, void* d_ws, size_t ws_size, hipStream_t stream) {
    static int grid = 0;
    if (grid == 0) {
        if (n_in != 29 || (size_t)out_size != O_END || ws_size < WS_END) {
            fprintf(stderr, "kernel_launch: built for 29 inputs, %zu outputs, >= %zu bytes of workspace; got n_in %d, out %d, ws %zu; nothing launched\n", (size_t)O_END, (size_t)WS_END, n_in, out_size, ws_size);
            grid = -1; return;
        }
        int dev = 0, cus = 0;
        if (hipGetDevice(&dev) != hipSuccess || hipDeviceGetAttribute(&cus, hipDeviceAttributeMultiprocessorCount, dev) != hipSuccess) { grid = -1; return; }
        if (hipFuncSetAttribute((const void*)yoco_fwd, hipFuncAttributeMaxDynamicSharedMemorySize, LDS_BYTES) != hipSuccess) { fprintf(stderr, "kernel_launch: hipFuncSetAttribute failed\n"); grid = -1; return; }
        (void)hipGetLastError();
        grid = cus;
    }
    if (grid < 0) return;
    if (hipMemsetAsync((char*)d_ws + WS_CTL, 0, CTL_ZERO_BYTES, stream) != hipSuccess) { fprintf(stderr, "kernel_launch: hipMemsetAsync failed\n"); return; }
    Args a{};
    for (int i = 0; i < 29; ++i) a.in[i] = (const float*)d_in[i];
    a.out = (float*)d_out; a.ws = (unsigned char*)d_ws;
#if MK_N_LAUNCHES == 1
    a.ph_lo = 0; a.ph_hi = NPHASE;
    hipLaunchKernelGGL(yoco_fwd, dim3(grid), dim3(NWAVES * 64), LDS_BYTES, stream, a);
#else
    for (int ph = 0; ph < NPHASE; ++ph) { a.ph_lo = ph; a.ph_hi = ph + 1; hipLaunchKernelGGL(yoco_fwd, dim3(grid), dim3(NWAVES * 64), LDS_BYTES, stream, a); }
#endif
    const hipError_t le = hipPeekAtLastError();
    if (le != hipSuccess) fprintf(stderr, "kernel_launch: launch failed: %s (grid %d)\n", hipGetErrorName(le), grid);
}
```

```cpp
#include <hip/hip_runtime.h>
#include <cstdio>
#include <cstdint>
namespace pg8 {
#define PG8_LAS __attribute__((address_space(3)))
typedef unsigned short bf16_t;
typedef short bf16x8 __attribute__((ext_vector_type(8)));
typedef float f32x4 __attribute__((ext_vector_type(4)));
typedef unsigned u32x4 __attribute__((ext_vector_type(4)));
constexpr int BM = 256, BK = 64, HALF = 128, HTB = HALF * BK * 2  , STAGE_BYTES = 8 * HTB, NXCD = 8, WGM = 8;

__host__ __device__ __forceinline__ int lds_byte(int r, int c) { const int st = (r >> 4) * 2 + (c >> 5), rr = r & 15, cc = c & 31, ob = rr * 64 + cc * 2; return st * 1024 + (ob ^ (((ob >> 9) & 1) << 5)); }
__host__ __device__ __forceinline__ void stage_rc(int b, int& R, int& C) { const int st = b / 1024, sb = b % 1024, swz = sb ^ (((sb >> 9) & 1) << 5); R = (st >> 1) * 16 + swz / 64; C = (st & 1) * 32 + (swz % 64) / 2; }
__host__ __device__ __forceinline__ int perm32(int rho) { const int n = rho >> 4, i = rho & 15; return 8 * (i >> 2) + 4 * n + (i & 3); }

struct Unit { int pm, pn, pb; };
struct Gemm { const bf16_t* A; const bf16_t* Bt; int M, N, K; };

struct StaticOrder {
    int nM, nN, nwg, G, c, mper;
    __host__ __device__ void init(int M, int N, int G_, int c_, int mper_ = 1 << 28) { nM = M / BM; nN = N / BM; nwg = nM * nN; G = G_; c = c_; mper = mper_; }
    __host__ __device__ bool next(int i, Unit& u) const {
        const long L = (long)i * G + c; if (L >= nwg) return false;
        int wgid = (int)L; { const int q = nwg / NXCD, r = nwg % NXCD, xcd = wgid % NXCD, off = wgid / NXCD; wgid = (xcd < r ? xcd * (q + 1) : r * (q + 1) + (xcd - r) * q) + off; }
        const int nig = WGM * nN, gid = wgid / nig, fm = gid * WGM, gsz = (nM - fm) < WGM ? (nM - fm) : WGM;
        u.pm = fm + ((wgid % nig) % gsz); u.pn = (wgid % nig) / gsz; u.pb = ((u.pm >= mper) + (u.pm >= 2 * mper) + (u.pm >= 3 * mper)) * nN + u.pn; return true;
    }
    __device__ __forceinline__ void a_ready(const Unit&) const {}
    __device__ __forceinline__ void done(const Unit&) const {}
};
__device__ __forceinline__ unsigned cvt_pk_bf16(float lo, float hi) { unsigned r; asm volatile("v_cvt_pk_bf16_f32 %0, %1, %2" : "=v"(r) : "v"(lo), "v"(hi)); return r; }
typedef float f32x2 __attribute__((ext_vector_type(2)));
template <class Epi, class Sched, bool ALIGN_EPI = false, bool SP2 = false>
__device__ __forceinline__ void gemm_phase(PG8_LAS unsigned char* lds, const Gemm g, const Sched& S, const Epi& E, int tid_in) {
    int tid_ = tid_in; asm volatile("" : "+v"(tid_));
    const int tid = tid_, wid = __builtin_amdgcn_readfirstlane(tid >> 6), lane = tid & 63, wr = wid >> 2, wc = wid & 3, fr = lane & 15, fq = lane >> 4;
    const int K = g.K, nt = K / BK;
    unsigned voffA[2], voffB[2];
#pragma unroll
    for (int i = 0; i < 2; ++i) { int R, C; stage_rc(tid * 16 + i * 8192, R, C); const int Rb = Epi::PERM ? ((R & ~31) + perm32(R & 31)) : R;
        voffA[i] = (unsigned)(R * K + C) * 2u; voffB[i] = (unsigned)(Rb * K + C) * 2u; }
    const size_t kstep = (size_t)(BK * 2);
    const size_t hstep = (size_t)HALF * K * 2;
    const size_t tstep = 2 * hstep;
    const unsigned ldsw = (unsigned)wid * 1024u;
    const int aoff = lds_byte(wr * 64 + fr, fq * 8), boff = lds_byte(wc * 32 + fr, fq * 8);
#define PG8_SA(b, h) (((b) * 2 + (h)) * HTB)
#define PG8_SB(b, h) ((4 + (b) * 2 + (h)) * HTB)
#define PG8_STAGE(bufoff, gbase, voff) do { _Pragma("unroll") for (int _i = 0; _i < 2; ++_i) \
        __builtin_amdgcn_global_load_lds((const unsigned*)((const char*)(gbase) + (voff)[_i]), (PG8_LAS unsigned*)(lds + (bufoff) + ldsw + _i * 8192), 16, 0, 0); } while (0)
#define PG8_LDA(dst, b, h) do { _Pragma("unroll") for (int m = 0; m < 4; ++m) _Pragma("unroll") for (int k = 0; k < 2; ++k) dst[m][k] = *(const PG8_LAS bf16x8*)(lds + PG8_SA(b, h) + aoff + m * 2048 + k * 1024); } while (0)
#define PG8_LDB(dst, b, h) do { _Pragma("unroll") for (int n = 0; n < 2; ++n) _Pragma("unroll") for (int k = 0; k < 2; ++k) dst[n][k] = *(const PG8_LAS bf16x8*)(lds + PG8_SB(b, h) + boff + n * 2048 + k * 1024); } while (0)
#define PG8_MMA(ai, bj, At, Bt) do { __builtin_amdgcn_s_setprio(1); _Pragma("unroll") for (int m = 0; m < 4; ++m) _Pragma("unroll") for (int n = 0; n < 2; ++n) _Pragma("unroll") for (int k = 0; k < 2; ++k) \
        acc[ai][bj][m][n] = __builtin_amdgcn_mfma_f32_16x16x32_bf16(Bt[n][k], At[m][k], acc[ai][bj][m][n], 0, 0, 0); __builtin_amdgcn_s_setprio(0); } while (0)
#define PG8_WAIT_V(n) asm volatile("s_waitcnt vmcnt(" #n ")" ::: "memory")
#define PG8_WAIT_L(n) asm volatile("s_waitcnt lgkmcnt(" #n ")" ::: "memory")
#define PG8_BAR __builtin_amdgcn_s_barrier()
#define PG8_SCHED __builtin_amdgcn_sched_barrier(0)
    Unit cur, nxt; int ui = 0;
    if (!S.next(0, cur)) return;
    f32x4 acc[2][2][4][2];
#pragma unroll
    for (int a = 0; a < 2; ++a)
#pragma unroll
        for (int b = 0; b < 2; ++b)
#pragma unroll
            for (int m = 0; m < 4; ++m)
#pragma unroll
                for (int n = 0; n < 2; ++n) acc[a][b][m][n] = (f32x4){0.f, 0.f, 0.f, 0.f};
    bf16x8 At[4][2], B0[2][2], B1[2][2];
    const char* cA = (const char*)g.A + (size_t)cur.pm * tstep; const char* cB = (const char*)g.Bt + (size_t)cur.pb * tstep;
    S.a_ready(cur);
    if constexpr (SP2) {
        PG8_STAGE(PG8_SB(0, 0), cB, voffB); PG8_STAGE(PG8_SB(0, 1), cB + hstep, voffB); PG8_STAGE(PG8_SA(0, 0), cA, voffA); PG8_STAGE(PG8_SA(0, 1), cA + hstep, voffA);
        if (wr == 1) PG8_BAR;
        PG8_WAIT_V(2); PG8_BAR;
        PG8_STAGE(PG8_SB(1, 0), cB + kstep, voffB); PG8_STAGE(PG8_SA(1, 0), cA + kstep, voffA); PG8_STAGE(PG8_SB(1, 1), cB + hstep + kstep, voffB);
        PG8_WAIT_V(6); PG8_BAR;
    } else {
        PG8_STAGE(PG8_SB(0, 0), cB, voffB); PG8_STAGE(PG8_SA(0, 0), cA, voffA); PG8_STAGE(PG8_SB(0, 1), cB + hstep, voffB); PG8_STAGE(PG8_SA(0, 1), cA + hstep, voffA);
        if (wr == 1) PG8_BAR;
        PG8_WAIT_V(4); PG8_BAR;
        PG8_STAGE(PG8_SB(1, 0), cB + kstep, voffB); PG8_STAGE(PG8_SA(1, 0), cA + kstep, voffA); PG8_STAGE(PG8_SB(1, 1), cB + hstep + kstep, voffB);
        PG8_WAIT_V(6); PG8_BAR;
    }
    for (;;) {
        const bool has_next = S.next(ui + 1, nxt);
        const char* nA = has_next ? (const char*)g.A + (size_t)nxt.pm * tstep : cA; const char* nB = has_next ? (const char*)g.Bt + (size_t)nxt.pb * tstep : cB;
        for (int t = 0; t < nt; t += 2) {
            const bool last = (t == nt - 2);
            const char* a1 = cA + (size_t)(t + 1) * kstep;
            const char* a2 = last ? nA : cA + (size_t)(t + 2) * kstep; const char* b2 = last ? nB : cB + (size_t)(t + 2) * kstep;
            const char* a3 = a2 + kstep; const char* b3 = b2 + kstep;
            if (last && has_next) S.a_ready(nxt);
            if constexpr (SP2) {
            PG8_LDB(B0, 0, 0); PG8_LDB(B1, 0, 1); PG8_SCHED; PG8_LDA(At, 0, 0); PG8_STAGE(PG8_SA(1, 1), a1 + hstep, voffA);
            PG8_WAIT_V(8); PG8_WAIT_L(0); PG8_BAR; PG8_MMA(0, 0, At, B0); PG8_MMA(0, 1, At, B1); PG8_BAR; PG8_SCHED;
            PG8_LDA(At, 0, 1); PG8_STAGE(PG8_SB(0, 0), b2, voffB); PG8_STAGE(PG8_SB(0, 1), b2 + hstep, voffB); PG8_STAGE(PG8_SA(0, 0), a2, voffA);
            PG8_WAIT_V(8); PG8_WAIT_L(0); PG8_BAR; PG8_MMA(1, 0, At, B0); PG8_MMA(1, 1, At, B1); PG8_BAR; PG8_SCHED;
            PG8_LDB(B0, 1, 0); PG8_LDB(B1, 1, 1); PG8_SCHED; PG8_LDA(At, 1, 0); PG8_STAGE(PG8_SA(0, 1), a2 + hstep, voffA);
            PG8_WAIT_V(8); PG8_WAIT_L(0); PG8_BAR; PG8_MMA(0, 0, At, B0); PG8_MMA(0, 1, At, B1); PG8_BAR; PG8_SCHED;
            PG8_LDA(At, 1, 1); PG8_STAGE(PG8_SB(1, 0), b3, voffB); PG8_STAGE(PG8_SB(1, 1), b3 + hstep, voffB); PG8_STAGE(PG8_SA(1, 0), a3, voffA);
            PG8_WAIT_V(8); PG8_WAIT_L(0); PG8_BAR; PG8_MMA(1, 0, At, B0); PG8_MMA(1, 1, At, B1); PG8_BAR; PG8_SCHED;
            } else {
            PG8_LDB(B0, 0, 0); PG8_SCHED; PG8_LDA(At, 0, 0); PG8_STAGE(PG8_SA(1, 1), a1 + hstep, voffA);
            PG8_WAIT_L(8); PG8_BAR; PG8_WAIT_L(0); PG8_MMA(0, 0, At, B0); PG8_BAR; PG8_SCHED;
            PG8_LDB(B1, 0, 1); PG8_STAGE(PG8_SB(0, 0), b2, voffB);
            PG8_BAR; PG8_WAIT_L(0); PG8_MMA(0, 1, At, B1); PG8_BAR;
            PG8_LDA(At, 0, 1); PG8_STAGE(PG8_SA(0, 0), a2, voffA);
            PG8_BAR; PG8_WAIT_L(0); PG8_MMA(1, 0, At, B0); PG8_BAR; PG8_SCHED;
            PG8_STAGE(PG8_SB(0, 1), b2 + hstep, voffB);
            PG8_WAIT_V(6); PG8_BAR; PG8_MMA(1, 1, At, B1); PG8_BAR;
            PG8_LDB(B0, 1, 0); PG8_SCHED; PG8_LDA(At, 1, 0); PG8_STAGE(PG8_SA(0, 1), a2 + hstep, voffA);
            PG8_WAIT_L(8); PG8_BAR; PG8_WAIT_L(0); PG8_MMA(0, 0, At, B0); PG8_BAR; PG8_SCHED;
            PG8_LDB(B1, 1, 1); PG8_STAGE(PG8_SB(1, 0), b3, voffB);
            PG8_BAR; PG8_WAIT_L(0); PG8_MMA(0, 1, At, B1); PG8_BAR;
            PG8_LDA(At, 1, 1); PG8_STAGE(PG8_SA(1, 0), a3, voffA);
            PG8_BAR; PG8_WAIT_L(0); PG8_MMA(1, 0, At, B0); PG8_BAR; PG8_SCHED;
            PG8_STAGE(PG8_SB(1, 1), b3 + hstep, voffB);
            PG8_WAIT_V(6); PG8_BAR; PG8_MMA(1, 1, At, B1); PG8_BAR;
            }
        }
        if constexpr (ALIGN_EPI) { if (wr == 0) PG8_BAR; }
        if constexpr (!Epi::AFTER_DRAIN) { E(acc, cur, wr, wc, fr, fq); S.done(cur); }
        if (!has_next) break;
#pragma unroll
        for (int a = 0; a < 2; ++a)
#pragma unroll
            for (int b = 0; b < 2; ++b)
#pragma unroll
                for (int m = 0; m < 4; ++m)
#pragma unroll
                    for (int n = 0; n < 2; ++n) acc[a][b][m][n] = (f32x4){0.f, 0.f, 0.f, 0.f};
        cur = nxt; cA = nA; cB = nB; ++ui;
        if constexpr (ALIGN_EPI) { if (wr == 1) PG8_BAR; }
    }
    PG8_WAIT_V(0);
    if constexpr (!ALIGN_EPI) { if (wr == 0) PG8_BAR; }
    PG8_BAR;
    if constexpr (Epi::AFTER_DRAIN) { E.fused(acc, cur, wr, wc, fr, fq, lds, wid, lane); S.done(cur); }
#undef PG8_SA
#undef PG8_SB
#undef PG8_STAGE
#undef PG8_LDA
#undef PG8_LDB
#undef PG8_MMA
#undef PG8_WAIT_V
#undef PG8_WAIT_L
#undef PG8_BAR
#undef PG8_SCHED
}
}

#ifndef MK_N_LAUNCHES
#define MK_N_LAUNCHES 1
#endif
constexpr int NWAVES = 8;
constexpr int TP = 16384, TS = 1024, T = TP + TS;
constexpr int D = 1024, DSGU = 2048, NEXP = 16384, DPLE = 256;
constexpr int NPHASE = 34;
constexpr float ALPHA = 1.681792830507429f;
constexpr float LN_EPS = 1e-5f;
constexpr size_t O_YP = 0, O_YS = 16777216, O_KP = 17825792, O_VP = 17858560, O_KS = 17891328, O_VS = 19988480, O_SGU = 22085632, O_END = 26279936;

constexpr size_t MiB = 1u << 20;
constexpr size_t WS_CTL = 0, CTL_ZERO_BYTES = 65536;
constexpr size_t WS_STATS = 925 * MiB;
constexpr size_t WS_WIN = 2 * MiB;
constexpr size_t WS_WOUT = 18 * MiB;
constexpr size_t WS_WQKV = 26 * MiB;
constexpr size_t WS_WQ1 = 29 * MiB;
constexpr size_t WS_WO = 31 * MiB;
constexpr size_t WS_WQK = 35 * MiB;
constexpr size_t WS_PLE = 51 * MiB;
constexpr size_t WS_GATE = 53 * MiB;
constexpr size_t WS_WSB = 61 * MiB;
constexpr size_t WS_PU = 64 * MiB;
constexpr size_t WS_PV = 192 * MiB;
constexpr size_t WS_PBF = 320 * MiB;
constexpr size_t WS_PP = 354 * MiB;
constexpr size_t WS_HF = 490 * MiB;
constexpr size_t WS_HB = 558 * MiB;
constexpr size_t WS_PRE = 592 * MiB;
constexpr size_t WS_Z = 660 * MiB;
constexpr size_t WS_SC = 660 * MiB;
constexpr size_t WS_GATED = 796 * MiB;
constexpr size_t WS_QB = 796 * MiB;
constexpr size_t WS_ATT = 830 * MiB;
constexpr size_t WS_EIDX = 864 * MiB;
constexpr size_t WS_GW = 873 * MiB;
constexpr size_t WS_KVB = 882 * MiB;
constexpr size_t WS_HB2 = 891 * MiB;
constexpr size_t WS_END = 930 * MiB;
constexpr int CW_BAR = 4096;

constexpr int RING_BYTES = 131072;
constexpr int LDSCTL_OFF = RING_BYTES, MISC_OFF = LDSCTL_OFF + 320;
constexpr int LDS_BYTES = 147456;

#define GAS __attribute__((address_space(1)))
#define LAS __attribute__((address_space(3)))
typedef unsigned short bf16;
typedef unsigned v4u __attribute__((ext_vector_type(4)));
typedef unsigned v2u __attribute__((ext_vector_type(2)));
typedef float f32x4 __attribute__((ext_vector_type(4)));
typedef float f32x2 __attribute__((ext_vector_type(2)));
typedef float f32x16 __attribute__((ext_vector_type(16)));
typedef short bf16x8 __attribute__((ext_vector_type(8)));
typedef short s16x4 __attribute__((ext_vector_type(4)));
typedef __bf16 bf16x2v __attribute__((ext_vector_type(2)));
typedef GAS unsigned gu32;
#define RLX_AGENT __ATOMIC_RELAXED, __HIP_MEMORY_SCOPE_AGENT
#define LDS_WAIT() asm volatile("s_waitcnt lgkmcnt(0)" ::: "memory")
#define VM_WAIT() asm volatile("s_waitcnt vmcnt(0)" ::: "memory")
__device__ __forceinline__ unsigned f2bf(float f) { unsigned u = __builtin_bit_cast(unsigned, f); return (u + 0x7fffu + ((u >> 16) & 1u)) >> 16; }
typedef __bf16 bf2v __attribute__((ext_vector_type(2)));
__device__ __forceinline__ unsigned pk2(float lo, float hi) { const bf2v v = {(__bf16)lo, (__bf16)hi}; return __builtin_bit_cast(unsigned, v); }
__device__ __forceinline__ float bflo(unsigned w) { return __builtin_bit_cast(float, w << 16); }
__device__ __forceinline__ float bfhi(unsigned w) { return __builtin_bit_cast(float, w & 0xffff0000u); }
__device__ __forceinline__ float bf2f(bf16 b) { return __builtin_bit_cast(float, ((unsigned)b) << 16); }
__device__ __forceinline__ float dot2_bf16(unsigned w, unsigned x, float acc) { return __builtin_amdgcn_fdot2_f32_bf16(__builtin_bit_cast(bf16x2v, w), __builtin_bit_cast(bf16x2v, x), acc, false); }
__device__ __forceinline__ float fexp2(float x) { return __builtin_amdgcn_exp2f(x); }
__device__ __forceinline__ float frcp(float x) { return __builtin_amdgcn_rcpf(x); }
__device__ __forceinline__ float gelu_tanh(float x) {
    const float t = x * (0.7978845608028654f + 0.035677408136300125f * x * x);
    return x * frcp(1.0f + fexp2(-2.8853900817779268f * t));
}
__device__ __forceinline__ float sigmoidf_(float x) { return frcp(1.0f + fexp2(-1.4426950408889634f * x)); }
__device__ __forceinline__ float row16_sum(float v) {
    v += __builtin_bit_cast(float, __builtin_amdgcn_update_dpp(0, __builtin_bit_cast(int, v), 0xB1, 0xF, 0xF, true));
    v += __builtin_bit_cast(float, __builtin_amdgcn_update_dpp(0, __builtin_bit_cast(int, v), 0x4E, 0xF, 0xF, true));
    v += __builtin_bit_cast(float, __builtin_amdgcn_update_dpp(0, __builtin_bit_cast(int, v), 0x141, 0xF, 0xF, true));
    v += __builtin_bit_cast(float, __builtin_amdgcn_update_dpp(0, __builtin_bit_cast(int, v), 0x140, 0xF, 0xF, true));
    return v;
}

__device__ __forceinline__ float bperm(int src_lane, float v) { return __builtin_bit_cast(float, __builtin_amdgcn_ds_bpermute(src_lane << 2, __builtin_bit_cast(int, v))); }
__device__ __forceinline__ float wave_sum(float v) {
    v = row16_sum(v);
    v += __builtin_bit_cast(float, __builtin_amdgcn_update_dpp(0, __builtin_bit_cast(int, v), 0x142, 0xA, 0xF, false));
    v += __builtin_bit_cast(float, __builtin_amdgcn_update_dpp(0, __builtin_bit_cast(int, v), 0x143, 0xC, 0xF, false));
    return __builtin_bit_cast(float, __builtin_amdgcn_readlane(__builtin_bit_cast(int, v), 63));
}
__device__ __forceinline__ float wave_max(float v) {
    const int ninf = (int)0xff800000u;
    v = fmaxf(v, __builtin_bit_cast(float, __builtin_amdgcn_update_dpp(ninf, __builtin_bit_cast(int, v), 0xB1, 0xF, 0xF, false)));
    v = fmaxf(v, __builtin_bit_cast(float, __builtin_amdgcn_update_dpp(ninf, __builtin_bit_cast(int, v), 0x4E, 0xF, 0xF, false)));
    v = fmaxf(v, __builtin_bit_cast(float, __builtin_amdgcn_update_dpp(ninf, __builtin_bit_cast(int, v), 0x141, 0xF, 0xF, false)));
    v = fmaxf(v, __builtin_bit_cast(float, __builtin_amdgcn_update_dpp(ninf, __builtin_bit_cast(int, v), 0x140, 0xF, 0xF, false)));
    v = fmaxf(v, __builtin_bit_cast(float, __builtin_amdgcn_update_dpp(ninf, __builtin_bit_cast(int, v), 0x142, 0xA, 0xF, false)));
    v = fmaxf(v, __builtin_bit_cast(float, __builtin_amdgcn_update_dpp(ninf, __builtin_bit_cast(int, v), 0x143, 0xC, 0xF, false)));
    return __builtin_bit_cast(float, __builtin_amdgcn_readlane(__builtin_bit_cast(int, v), 63));
}
#define XB_TMO      128
#define XB_XCNT(j)  (256  + 64 * (j))
#define XB_XSUB(j)  (1280 + 64 * (j))
#define XB_XGEN(j)  (2304 + 64 * (j))
#define XB_TOP      3328
#define XB_TOPGEN   3392
#define XCD_BAR_WORDS 3456
#define XB_SPIN_CAP (1u << 18)

__device__ __forceinline__ unsigned xb_ld(unsigned* p)              { return __hip_atomic_load(p, __ATOMIC_RELAXED, __HIP_MEMORY_SCOPE_AGENT); }
__device__ __forceinline__ unsigned xb_add(unsigned* p, unsigned v) { return __hip_atomic_fetch_add(p, v, __ATOMIC_RELAXED, __HIP_MEMORY_SCOPE_AGENT); }
__device__ __forceinline__ unsigned xb_xcc_id() { return (unsigned)__builtin_amdgcn_s_getreg((3 << 11) | 20) & 0xFu; }
#define XB_SPIN(cond, bar) do { unsigned _sp = 0; while (cond) { __builtin_amdgcn_s_sleep(1); \
    if ((++_sp & 255u) == 0u) { if (xb_ld(&(bar)[XB_TMO])) break; if (_sp > XB_SPIN_CAP) { atomicAdd(&(bar)[XB_TMO], 1u); break; } } } } while (0)

struct XcdBarrier {
    unsigned* bar; unsigned x;
    volatile LAS unsigned* st;
};

__device__ __forceinline__ XcdBarrier xcd_barrier_post(unsigned* bar, volatile LAS unsigned* st) {
    XcdBarrier b; b.bar = bar; b.x = xb_xcc_id(); b.st = st;
    if (threadIdx.x == 0) (void)xb_add(&bar[XB_XCNT(b.x)], 1u);
    return b;
}
__device__ __forceinline__ void xcd_barrier_complete(unsigned* bar, unsigned x, unsigned& nloc, unsigned& nx) {
    const unsigned G = gridDim.x * gridDim.y * gridDim.z;
    unsigned sum, cnt, mine, sp = 0u;
    for (;;) {
        sum = 0u; cnt = 0u; mine = 0u;
#pragma unroll
        for (unsigned j = 0; j < 16; ++j) { const unsigned c = xb_ld(&bar[XB_XCNT(j)]); sum += c; cnt += (c > 0u) ? 1u : 0u; mine = (j == x) ? c : mine; }
        if (sum == G) break;
        __builtin_amdgcn_s_sleep(1);
        if ((++sp & 255u) == 0u) { if (xb_ld(&bar[XB_TMO])) break; if (sp > XB_SPIN_CAP) { atomicAdd(&bar[XB_TMO], 1u); break; } }
    }
    nloc = mine > 0u ? mine : 1u; nx = cnt > 0u ? cnt : 1u;
}

__device__ __forceinline__ void xcd_barrier(const XcdBarrier& b, int tid) {
    asm volatile("s_waitcnt vmcnt(0)" ::: "memory");
    __syncthreads();
    if (tid == 0) {
        unsigned* bar = b.bar;
        __builtin_amdgcn_s_waitcnt(0);
        unsigned nloc = b.st[0], nx = b.st[1];
        if (nloc == 0u) { xcd_barrier_complete(bar, b.x, nloc, nx); b.st[0] = nloc; b.st[1] = nx; }
        const unsigned old = xb_add(&bar[XB_XSUB(b.x)], 1u);
        const unsigned gen = old / nloc;
        if (old + 1u == (gen + 1u) * nloc) {
            __builtin_amdgcn_fence(__ATOMIC_RELEASE, "agent");
            asm volatile("s_waitcnt vmcnt(0)" ::: "memory");
            const unsigned og = xb_add(&bar[XB_TOP], 1u);
            const unsigned tg = og / nx;
            if (og + 1u == (tg + 1u) * nx) xb_add(&bar[XB_TOPGEN], 1u);
            else XB_SPIN(xb_ld(&bar[XB_TOPGEN]) == tg, bar);
            __builtin_amdgcn_fence(__ATOMIC_ACQUIRE, "agent");
            xb_add(&bar[XB_XGEN(b.x)], 1u);
            asm volatile("s_waitcnt vmcnt(0)" ::: "memory");
        } else {
            XB_SPIN(xb_ld(&bar[XB_XGEN(b.x)]) == gen, bar);
            __builtin_amdgcn_fence(__ATOMIC_ACQUIRE, "agent");
            asm volatile("s_waitcnt vmcnt(0)" ::: "memory");
        }
    }
    __syncthreads();
}

struct Frame {
    LAS unsigned char* lds;
    volatile LAS unsigned* MISC;
    gu32* ctl;
    int tid, lane, wave, G, bx;
    float* out;
    unsigned char* ws;
};
#define IN_XP 0
#define IN_XS 1
#define IN_CK 2
#define IN_CV 3
#define IN_PPR 4
#define IN_PSA 5
#define IN_LN1G 6
#define IN_LN1B 7
#define IN_LN2G 8
#define IN_LN2B 9
#define IN_WIN 10
#define IN_BIN 11
#define IN_SLNG 12
#define IN_SLNB 13
#define IN_WS 14
#define IN_BS 15
#define IN_WOUT 16
#define IN_BOUT 17
#define IN_WKV 18
#define IN_WQ 19
#define IN_SINK 20
#define IN_WO 21
#define IN_PWQ 22
#define IN_SUBK 23
#define IN_PU 24
#define IN_PV 25
#define IN_PLEW 26
#define IN_GW 27
#define IN_GB 28

typedef const GAS float* CFPtr;
__device__ __forceinline__ const float* inp(int k) {
    const __attribute__((address_space(4))) CFPtr* ka = (const __attribute__((address_space(4))) CFPtr*)__builtin_amdgcn_kernarg_segment_ptr();
    asm volatile("" : "+s"(ka));
    return (const float*)ka[k];
}

using pg8::Unit;
typedef const f32x4 (&AccRef)[2][2][4][2];

struct EpiZ {
    static constexpr bool PERM = true, AFTER_DRAIN = false;
    bf16* Z; const float* bias; float* stats;
    __device__ __forceinline__ void operator()(AccRef acc, const Unit& u, int wr, int wc, int fr, int fq) const {
        asm volatile("" : "+v"(fr), "+v"(fq));
        const int row0 = u.pm * 256 + wr * 64 + fr, col0 = u.pn * 256 + wc * 32 + 8 * fq;
        const bool isv = u.pn >= 8;
        f32x4 bv[2][2];
#pragma unroll
        for (int bj = 0; bj < 2; ++bj)
#pragma unroll
            for (int n = 0; n < 2; ++n) bv[bj][n] = *(const f32x4*)(bias + col0 + bj * 128 + 4 * n);
#pragma unroll
        for (int ai = 0; ai < 2; ++ai)
#pragma unroll
            for (int m = 0; m < 4; ++m) {
                const int row = row0 + ai * 128 + m * 16;
                float s1 = 0.f, s2 = 0.f;
#pragma unroll
                for (int bj = 0; bj < 2; ++bj) {
                    f32x4 v0 = acc[ai][bj][m][0] + bv[bj][0], v1 = acc[ai][bj][m][1] + bv[bj][1];
#pragma unroll
                    for (int e = 0; e < 4; ++e) { v0[e] = gelu_tanh(v0[e]); v1[e] = gelu_tanh(v1[e]); }
                    v4u w; w.x = pk2(v0[0], v0[1]); w.y = pk2(v0[2], v0[3]); w.z = pk2(v1[0], v1[1]); w.w = pk2(v1[2], v1[3]);
                    *(v4u*)(Z + (size_t)row * 4096 + col0 + bj * 128) = w;
                    const float r0 = bflo(w.x), r1 = bfhi(w.x), r2 = bflo(w.y), r3 = bfhi(w.y), r4 = bflo(w.z), r5 = bfhi(w.z), r6 = bflo(w.w), r7 = bfhi(w.w);
                    s1 += ((r0 + r1) + (r2 + r3)) + ((r4 + r5) + (r6 + r7));
                    s2 += ((r0 * r0 + r1 * r1) + (r2 * r2 + r3 * r3)) + ((r4 * r4 + r5 * r5) + (r6 * r6 + r7 * r7));
                }
                if (isv) {
                    const int ln = fq * 16 + fr;
                    s1 += bperm(ln ^ 16, s1); s1 += bperm(ln ^ 32, s1);
                    s2 += bperm(ln ^ 16, s2); s2 += bperm(ln ^ 32, s2);
                    if (fq == 0) *(f32x2*)(stats + ((size_t)row * 32 + (u.pn - 8) * 4 + wc) * 2) = (f32x2){s1, s2};
                }
            }
    }
};

struct EpiPre {
    static constexpr bool PERM = false, AFTER_DRAIN = false;
    bf16* pre; const bf16* hin; const float* bias;
    __device__ __forceinline__ void apply4(int row, int col, f32x4 a) const {
        const size_t o = (size_t)row * D + col;
        const f32x4 bv = bias ? *(const f32x4*)(bias + col) : (f32x4){0.f, 0.f, 0.f, 0.f};
        const v2u hw = *(const v2u*)(hin + o); const f32x4 h = (f32x4){bflo(hw.x), bfhi(hw.x), bflo(hw.y), bfhi(hw.y)};
        { const f32x4 r = h * ALPHA + a + bv; v2u w; w.x = pk2(r[0], r[1]); w.y = pk2(r[2], r[3]); *(v2u*)(pre + o) = w; }
    }
    __device__ __forceinline__ void operator()(AccRef acc, const Unit& u, int wr, int wc, int fr, int fq) const {
        asm volatile("" : "+v"(fr), "+v"(fq));
        const int row0 = u.pm * 256 + wr * 64 + fr, col0 = u.pn * 256 + wc * 32 + 4 * fq;
        f32x4 bv[2][2];
#pragma unroll
        for (int bj = 0; bj < 2; ++bj)
#pragma unroll
            for (int n = 0; n < 2; ++n) bv[bj][n] = bias ? *(const f32x4*)(bias + col0 + bj * 128 + n * 16) : (f32x4){0.f, 0.f, 0.f, 0.f};
#pragma unroll
        for (int ai = 0; ai < 2; ++ai) {
            v2u hq[4][2][2];
#pragma unroll
            for (int m = 0; m < 4; ++m)
#pragma unroll
                for (int bj = 0; bj < 2; ++bj)
#pragma unroll
                    for (int n = 0; n < 2; ++n) hq[m][bj][n] = *(const v2u*)(hin + (size_t)(row0 + ai * 128 + m * 16) * D + col0 + bj * 128 + n * 16);
#pragma unroll
            for (int m = 0; m < 4; ++m) {
                const size_t ro = (size_t)(row0 + ai * 128 + m * 16) * D + col0;
#pragma unroll
                for (int bj = 0; bj < 2; ++bj)
#pragma unroll
                    for (int n = 0; n < 2; ++n) {
                        const v2u hw = hq[m][bj][n]; const f32x4 h = (f32x4){bflo(hw.x), bfhi(hw.x), bflo(hw.y), bfhi(hw.y)};
                        { const f32x4 r = h * ALPHA + acc[ai][bj][m][n] + bv[bj][n]; v2u w; w.x = pk2(r[0], r[1]); w.y = pk2(r[2], r[3]); *(v2u*)(pre + ro + bj * 128 + n * 16) = w; }
                    }
            }
        }
    }
};

struct EpiF32 {
    static constexpr bool PERM = false, AFTER_DRAIN = false;
    unsigned* C; int ldc;
    __device__ __forceinline__ void operator()(AccRef acc, const Unit& u, int wr, int wc, int fr, int fq) const {
        asm volatile("" : "+v"(fr), "+v"(fq));
        const int row0 = u.pm * 128 + wr * 64 + fr, col0 = u.pn * 256 + wc * 32 + 4 * fq;
#pragma unroll
        for (int m = 0; m < 4; ++m) {
            unsigned* rowp = C + (size_t)(row0 + m * 16) * ldc + col0;
#pragma unroll
            for (int bj = 0; bj < 2; ++bj)
#pragma unroll
                for (int n = 0; n < 2; ++n) {
                    const f32x4 a0 = acc[0][bj][m][n], a1 = acc[1][bj][m][n];
                    *(v4u*)(rowp + bj * 128 + n * 16) = (v4u){pk2(a0[0], a1[0]), pk2(a0[1], a1[1]), pk2(a0[2], a1[2]), pk2(a0[3], a1[3])};
                }
        }
    }
};

struct EpiBf {
    static constexpr bool PERM = true, AFTER_DRAIN = false;
    bf16* O; int ldc;
    __device__ __forceinline__ void apply4(int row, int col, f32x4 a) const { v2u w; w.x = pk2(a[0], a[1]); w.y = pk2(a[2], a[3]); *(v2u*)(O + (size_t)row * ldc + col) = w; }
    __device__ __forceinline__ void operator()(AccRef acc, const Unit& u, int wr, int wc, int fr, int fq) const {
        asm volatile("" : "+v"(fr), "+v"(fq));
        const int row0 = u.pm * 256 + wr * 64 + fr, col0 = u.pn * 256 + wc * 32 + 8 * fq;
#pragma unroll
        for (int ai = 0; ai < 2; ++ai)
#pragma unroll
            for (int m = 0; m < 4; ++m) {
                bf16* rowp = O + (size_t)(row0 + ai * 128 + m * 16) * ldc + col0;
#pragma unroll
                for (int bj = 0; bj < 2; ++bj) {
                    const f32x4 v0 = acc[ai][bj][m][0], v1 = acc[ai][bj][m][1];
                    v4u w; w.x = pk2(v0[0], v0[1]); w.y = pk2(v0[2], v0[3]); w.z = pk2(v1[0], v1[1]); w.w = pk2(v1[2], v1[3]);
                    *(v4u*)(rowp + bj * 128) = w;
                }
            }
    }
};

struct EpiGate {
    static constexpr bool PERM = false, AFTER_DRAIN = false;
    const bf16* hin; bf16* hb; const bf16* pp; const float* gb; float* yout;
    __device__ __forceinline__ void apply4(int row, int col, f32x4 acc4) const {
        const size_t o = (size_t)row * D + col;
        const v2u hw = *(const v2u*)(hin + o); const f32x4 h = (f32x4){bflo(hw.x), bfhi(hw.x), bflo(hw.y), bfhi(hw.y)}; const v2u pw = *(const v2u*)(pp + o); const f32x4 a = acc4 + *(const f32x4*)(gb + col);
        f32x4 r;
        r[0] = h[0] + sigmoidf_(a[0]) * bflo(pw.x); r[1] = h[1] + sigmoidf_(a[1]) * bfhi(pw.x);
        r[2] = h[2] + sigmoidf_(a[2]) * bflo(pw.y); r[3] = h[3] + sigmoidf_(a[3]) * bfhi(pw.y);
        if (yout) { *(f32x4*)(yout + o) = r; }
        else { v2u w; w.x = pk2(r[0], r[1]); w.y = pk2(r[2], r[3]); *(v2u*)(hb + o) = w; }
    }
    __device__ __forceinline__ void operator()(AccRef acc, const Unit& u, int wr, int wc, int fr, int fq) const {
        asm volatile("" : "+v"(fr), "+v"(fq));
        const int row0 = u.pm * 256 + wr * 64 + fr, col0 = u.pn * 256 + wc * 32 + 4 * fq;
        f32x4 bv[2][2];
#pragma unroll
        for (int bj = 0; bj < 2; ++bj)
#pragma unroll
            for (int n = 0; n < 2; ++n) bv[bj][n] = *(const f32x4*)(gb + col0 + bj * 128 + n * 16);
#pragma unroll
        for (int ai = 0; ai < 2; ++ai) {
            v2u hq[4][2][2], pq[4][2][2];
#pragma unroll
            for (int m = 0; m < 4; ++m)
#pragma unroll
                for (int bj = 0; bj < 2; ++bj)
#pragma unroll
                    for (int n = 0; n < 2; ++n) { const size_t o = (size_t)(row0 + ai * 128 + m * 16) * D + col0 + bj * 128 + n * 16; hq[m][bj][n] = *(const v2u*)(hin + o); pq[m][bj][n] = *(const v2u*)(pp + o); }
#pragma unroll
            for (int m = 0; m < 4; ++m) {
                const size_t ro = (size_t)(row0 + ai * 128 + m * 16) * D + col0;
#pragma unroll
                for (int bj = 0; bj < 2; ++bj)
#pragma unroll
                    for (int n = 0; n < 2; ++n) {
                        const size_t o = ro + bj * 128 + n * 16;
                        const v2u hw = hq[m][bj][n]; const f32x4 h = (f32x4){bflo(hw.x), bfhi(hw.x), bflo(hw.y), bfhi(hw.y)};
                        const v2u pw = pq[m][bj][n];
                        const f32x4 a = acc[ai][bj][m][n] + bv[bj][n];
                        f32x4 r;
                        r[0] = h[0] + sigmoidf_(a[0]) * bflo(pw.x); r[1] = h[1] + sigmoidf_(a[1]) * bfhi(pw.x);
                        r[2] = h[2] + sigmoidf_(a[2]) * bflo(pw.y); r[3] = h[3] + sigmoidf_(a[3]) * bfhi(pw.y);
                        if (yout) { *(f32x4*)(yout + o) = r; }
                        else { v2u w; w.x = pk2(r[0], r[1]); w.y = pk2(r[2], r[3]); *(v2u*)(hb + o) = w; }
                    }
            }
        }
    }
};

struct EpiQKV {
    static constexpr bool PERM = true, AFTER_DRAIN = false;
    bf16* qb; bf16* kvb; float* out;
    __device__ __forceinline__ void apply4(int row, int col, f32x4 a) const {
        v2u w; w.x = pk2(a[0], a[1]); w.y = pk2(a[2], a[3]); *(v2u*)(qb + (size_t)row * D + col) = w;
    }
    __device__ __forceinline__ void operator()(AccRef acc, const Unit& u, int wr, int wc, int fr, int fq) const {
        asm volatile("" : "+v"(fr), "+v"(fq));
        const int row0 = u.pm * 256 + wr * 64 + fr, cl = wc * 32 + 8 * fq;
        const bool iskv = u.pn >= 4;
#pragma unroll
        for (int ai = 0; ai < 2; ++ai)
#pragma unroll
            for (int m = 0; m < 4; ++m) {
                const int row = row0 + ai * 128 + m * 16;
#pragma unroll
                for (int bj = 0; bj < 2; ++bj) {
                    const f32x4 v0 = acc[ai][bj][m][0], v1 = acc[ai][bj][m][1];
                    v4u w; w.x = pk2(v0[0], v0[1]); w.y = pk2(v0[2], v0[3]); w.z = pk2(v1[0], v1[1]); w.w = pk2(v1[2], v1[3]);
                    const int c = cl + bj * 128;
                    if (!iskv) { *(v4u*)(qb + (size_t)row * D + u.pn * 256 + c) = w; }
                    else {
                        *(v4u*)(kvb + (size_t)row * 256 + c) = w;
                        long widx = -1;
                        size_t base = 0;
                        if (row < TP) { const int s = row & 8191; if (s >= 8064) { widx = (long)(row >> 13) * 128 + (s - 8064); base = (bj == 0) ? O_KP : O_VP; } }
                        else { const int r = row - TP; widx = (long)(r >> 3) * 128 + 120 + (r & 7); base = (bj == 0) ? O_KS : O_VS; }
                        if (widx >= 0) { float* o = out + base + (size_t)widx * 128 + cl; *(f32x4*)o = v0; *(f32x4*)(o + 4) = v1; }
                    }
                }
            }
    }
};

template <class Epi>
__device__ __forceinline__ void sgemm64(Frame& F, const bf16* A, const bf16* Bt, int row_base, int nrt, int nct, int K, const Epi& E) {
    constexpr int PS = 68;
    LAS float* part = (LAS float*)F.lds;
    const int lane = F.lane, fr = lane & 15, fq = lane >> 4, wk = F.wave & 3, wm = F.wave >> 2, kper = K / 4;
    for (int tile = F.bx; tile < nrt * nct; tile += F.G) {
        const int rt = tile / nct, ct = tile % nct, r0 = row_base + rt * 64, c0 = ct * 64;
        f32x4 acc[2][4];
#pragma unroll
        for (int mt = 0; mt < 2; ++mt)
#pragma unroll
            for (int nt = 0; nt < 4; ++nt) acc[mt][nt] = (f32x4){0.f, 0.f, 0.f, 0.f};
        const bf16* Ap = A + (size_t)(r0 + wm * 32 + fr) * K + wk * kper + fq * 8;
        const bf16* Bp = Bt + (size_t)(c0 + fr) * K + wk * kper + fq * 8;
#pragma unroll 4
        for (int ks = 0; ks < kper / 32; ++ks) {
            bf16x8 af[2], bfr[4];
#pragma unroll
            for (int mt = 0; mt < 2; ++mt) af[mt] = *(const bf16x8*)(Ap + (size_t)mt * 16 * K + ks * 32);
#pragma unroll
            for (int nt = 0; nt < 4; ++nt) bfr[nt] = *(const bf16x8*)(Bp + (size_t)nt * 16 * K + ks * 32);
#pragma unroll
            for (int mt = 0; mt < 2; ++mt)
#pragma unroll
                for (int nt = 0; nt < 4; ++nt) acc[mt][nt] = __builtin_amdgcn_mfma_f32_16x16x32_bf16(bfr[nt], af[mt], acc[mt][nt], 0, 0, 0);
        }
#pragma unroll
        for (int mt = 0; mt < 2; ++mt)
#pragma unroll
            for (int nt = 0; nt < 4; ++nt) *(LAS f32x4*)(part + (size_t)((wk * 64 + wm * 32 + mt * 16 + fr) * PS + nt * 16 + 4 * fq)) = acc[mt][nt];
        __syncthreads();
        {
            const int row = F.tid >> 3, cg = (F.tid & 7) * 8;
            f32x4 s0 = (f32x4){0.f, 0.f, 0.f, 0.f}, s1 = (f32x4){0.f, 0.f, 0.f, 0.f};
#pragma unroll
            for (int w = 0; w < 4; ++w) { s0 += *(const LAS f32x4*)(part + (size_t)((w * 64 + row) * PS + cg)); s1 += *(const LAS f32x4*)(part + (size_t)((w * 64 + row) * PS + cg + 4)); }
            E.apply4(r0 + row, c0 + cg, s0); E.apply4(r0 + row, c0 + cg + 4, s1);
        }
        __syncthreads();
    }
}

__device__ __forceinline__ void p0_transpose_item(const float* W, int K, int N, bf16* WT, int row_off, LAS float* scr, int item, int lane) {
    const int nblk = N / 32, kb = item / nblk, nb = item % nblk, k0 = 64 * kb, n0 = 32 * nb;
    f32x4 tv[8];
#pragma unroll
    for (int i = 0; i < 8; ++i) { const int kk = 8 * i + (lane >> 3); tv[i] = *(const f32x4*)(W + (size_t)(k0 + kk) * N + n0 + (lane & 7) * 4); }
#pragma unroll
    for (int i = 0; i < 8; ++i) { const int kk = 8 * i + (lane >> 3); LAS float* d = scr + kk * 33 + (lane & 7) * 4; d[0] = tv[i][0]; d[1] = tv[i][1]; d[2] = tv[i][2]; d[3] = tv[i][3]; }
    LDS_WAIT(); asm volatile("" ::: "memory");
    const int c = lane & 7;
#pragma unroll
    for (int j = 0; j < 4; ++j) { const int n = (lane >> 3) + 8 * j; const LAS float* s = scr + (8 * c) * 33 + n;
        v4u o; o.x = pk2(s[0 * 33], s[1 * 33]); o.y = pk2(s[2 * 33], s[3 * 33]); o.z = pk2(s[4 * 33], s[5 * 33]); o.w = pk2(s[6 * 33], s[7 * 33]);
        *(v4u*)(WT + (size_t)(row_off + n0 + n) * K + k0 + 8 * c) = o; }
    LDS_WAIT(); asm volatile("" ::: "memory");
}
__device__ __forceinline__ void p0_cvt(const float* src, bf16* dst, size_t n8, size_t gt, size_t ngt) {
    for (size_t i = gt; i < n8; i += 4 * ngt) {
        f32x4 a[4], b[4];
#pragma unroll
        for (int r = 0; r < 4; ++r) { const size_t j = (i + r * ngt < n8) ? i + r * ngt : i; a[r] = *(const f32x4*)(src + j * 8); b[r] = *(const f32x4*)(src + j * 8 + 4); }
#pragma unroll
        for (int r = 0; r < 4; ++r) {
            if (i + r * ngt < n8) {
                v4u w; w.x = pk2(a[r][0], a[r][1]); w.y = pk2(a[r][2], a[r][3]); w.z = pk2(b[r][0], b[r][1]); w.w = pk2(b[r][2], b[r][3]);
                *(v4u*)(dst + (i + r * ngt) * 8) = w;
            }
        }
    }
}
__device__ __forceinline__ void p0_cvt8(const float* src, unsigned char* dst, size_t n16, float scale, size_t gt, size_t ngt) {
    for (size_t i = gt; i < n16; i += 4 * ngt) {
        f32x4 a[4][4];
#pragma unroll
        for (int r = 0; r < 4; ++r) { const size_t j = (i + r * ngt < n16) ? i + r * ngt : i;
#pragma unroll
            for (int c = 0; c < 4; ++c) a[r][c] = *(const f32x4*)(src + j * 16 + 4 * c); }
#pragma unroll
        for (int r = 0; r < 4; ++r) {
            if (i + r * ngt < n16) {
                v4u w;
#pragma unroll
                for (int c = 0; c < 4; ++c) {
                    const f32x4 q = a[r][c] * scale;
                    int x = __builtin_amdgcn_cvt_pk_fp8_f32(q[0], q[1], 0, false);
                    x = __builtin_amdgcn_cvt_pk_fp8_f32(q[2], q[3], x, true);
                    w[c] = (unsigned)x;
                }
                *(v4u*)(dst + (i + r * ngt) * 16) = w;
            }
        }
    }
}
__device__ __forceinline__ void table_filler(Frame& F, int layer, int which, int nwg) {
    const int rem = nwg % F.G;
    int k = F.bx, n = F.G;
    if (rem) { if (F.bx < rem) return; k = F.bx - rem; n = F.G - rem; }
    const float* src = inp(which ? IN_PV : IN_PU) + (size_t)layer * NEXP * D;
    unsigned char* dst = (unsigned char*)(F.ws + (which ? WS_PV : WS_PU)) + (size_t)layer * NEXP * D;
    p0_cvt8(src, dst, (size_t)NEXP * D / 16, which ? 16.f : 64.f, (size_t)k * 512 + F.tid, (size_t)n * 512);
}
__device__ __forceinline__ void phase_prologue(Frame& F) {
    unsigned char* ws = F.ws;
    const int gw = F.bx * NWAVES + F.wave, NGW = F.G * NWAVES;
    const size_t gt = (size_t)F.bx * 512 + F.tid, ngt = (size_t)F.G * 512;
    LAS float* scr = (LAS float*)(F.lds + F.wave * 16384);
    {
        constexpr int I_WIN = (1024 / 64) * (4096 / 32), I_WOUT = (2048 / 64) * (1024 / 32), I_SQ = (1024 / 64) * (1024 / 32), I_KV = (1024 / 64) * (256 / 32), I_PLE = (256 / 64) * (1024 / 32);
        constexpr int NIT = 2 * I_WIN + 2 * I_WOUT + 2 * I_SQ + I_KV + 2 * I_SQ + 4 * I_PLE + 4 * I_SQ;
        for (int it = gw; it < NIT; it += NGW) {
            int r = it;
            if (r < 2 * I_WIN) { const int l = r / I_WIN; p0_transpose_item(inp(IN_WIN) + (size_t)l * 1024 * 4096, 1024, 4096, (bf16*)(ws + WS_WIN) + (size_t)l * 4096 * 1024, 0, scr, r % I_WIN, F.lane); continue; } r -= 2 * I_WIN;
            if (r < 2 * I_WOUT) { const int l = r / I_WOUT; p0_transpose_item(inp(IN_WOUT) + (size_t)l * 2048 * 1024, 2048, 1024, (bf16*)(ws + WS_WOUT) + (size_t)l * 1024 * 2048, 0, scr, r % I_WOUT, F.lane); continue; } r -= 2 * I_WOUT;
            if (r < I_SQ) { p0_transpose_item(inp(IN_WQ), 1024, 1024, (bf16*)(ws + WS_WQKV), 0, scr, r, F.lane); continue; } r -= I_SQ;
            if (r < I_SQ) { p0_transpose_item(inp(IN_WQ) + (size_t)1024 * 1024, 1024, 1024, (bf16*)(ws + WS_WQ1), 0, scr, r, F.lane); continue; } r -= I_SQ;
            if (r < I_KV) { p0_transpose_item(inp(IN_WKV), 1024, 256, (bf16*)(ws + WS_WQKV), 1024, scr, r, F.lane); continue; } r -= I_KV;
            if (r < 2 * I_SQ) { const int l = r / I_SQ; p0_transpose_item(inp(IN_WO) + (size_t)l * 1024 * 1024, 1024, 1024, (bf16*)(ws + WS_WO) + (size_t)l * 1024 * 1024, 0, scr, r % I_SQ, F.lane); continue; } r -= 2 * I_SQ;
            if (r < 4 * I_PLE) { const int l = r / I_PLE; p0_transpose_item(inp(IN_PLEW) + (size_t)l * 256 * 1024, 256, 1024, (bf16*)(ws + WS_PLE) + (size_t)l * 1024 * 256, 0, scr, r % I_PLE, F.lane); continue; } r -= 4 * I_PLE;
            { const int l = r / I_SQ; p0_transpose_item(inp(IN_GW) + (size_t)l * 1024 * 1024, 1024, 1024, (bf16*)(ws + WS_GATE) + (size_t)l * 1024 * 1024, 0, scr, r % I_SQ, F.lane); }
        }
    }
    __syncthreads();
    {
        LAS float* sk = (LAS float*)F.lds;
        LAS float* wq = (LAS float*)(F.lds + 128 * 132 * 4);
        for (int it = F.bx; it < 1024; it += F.G) {
            const int l = it >> 8, hp = (it >> 4) & 15, dc = it & 15, p = hp & 1;
            const float* skg = inp(IN_SUBK) + ((size_t)(l * 2 + p) * 128) * 128;
            const float* wqg = inp(IN_PWQ) + (size_t)l * 1024 * 2048 + (size_t)(dc * 64) * 2048 + hp * 128;
            for (int i = F.tid; i < 128 * 32; i += 512) *(LAS f32x4*)(sk + (i >> 5) * 132 + (i & 31) * 4) = *(const f32x4*)(skg + (size_t)i * 4);
            for (int i = F.tid; i < 64 * 32; i += 512) *(LAS f32x4*)(wq + (i >> 5) * 132 + (i & 31) * 4) = *(const f32x4*)(wqg + (size_t)(i >> 5) * 2048 + (i & 31) * 4);
            __syncthreads();
            const int ng = F.tid & 31, dg = F.tid >> 5;
            float a[4][4];
#pragma unroll
            for (int ni = 0; ni < 4; ++ni)
#pragma unroll
                for (int di = 0; di < 4; ++di) a[ni][di] = 0.f;
            for (int c4 = 0; c4 < 32; ++c4) {
                f32x4 sv[4], wv[4];
#pragma unroll
                for (int ni = 0; ni < 4; ++ni) sv[ni] = *(const LAS f32x4*)(sk + (ng + 32 * ni) * 132 + 4 * c4);
#pragma unroll
                for (int di = 0; di < 4; ++di) wv[di] = *(const LAS f32x4*)(wq + (4 * dg + di) * 132 + 4 * c4);
#pragma unroll
                for (int ni = 0; ni < 4; ++ni)
#pragma unroll
                    for (int di = 0; di < 4; ++di)
                        a[ni][di] += (sv[ni][0] * wv[di][0] + sv[ni][1] * wv[di][1]) + (sv[ni][2] * wv[di][2] + sv[ni][3] * wv[di][3]);
            }
#pragma unroll
            for (int ni = 0; ni < 4; ++ni) {
                bf16* o = (bf16*)(ws + WS_WQK) + ((size_t)l * 2048 + hp * 128 + ng + 32 * ni) * 1024 + dc * 64 + 4 * dg;
                v2u w0; w0.x = pk2(a[ni][0], a[ni][1]); w0.y = pk2(a[ni][2], a[ni][3]);
                *(v2u*)o = w0;
            }
            __syncthreads();
        }
    }
    for (int l = 0; l < 4; ++l) {
        p0_cvt(inp(IN_PPR) + (size_t)l * TP * DPLE, (bf16*)(ws + WS_PBF) + (size_t)l * T * DPLE, (size_t)TP * DPLE / 8, gt, ngt);
        p0_cvt(inp(IN_PSA) + (size_t)l * TS * DPLE, (bf16*)(ws + WS_PBF) + ((size_t)l * T + TP) * DPLE, (size_t)TS * DPLE / 8, gt, ngt);
    }
    {
        bf16* hb = (bf16*)(ws + WS_HB);
        for (size_t i0 = gt; i0 < (size_t)T * D / 8; i0 += 4 * ngt) {
            f32x4 a[4], b[4];
#pragma unroll
            for (int r = 0; r < 4; ++r) { const size_t i = (i0 + r * ngt < (size_t)T * D / 8) ? i0 + r * ngt : i0;
                const float* src = (i < (size_t)TP * D / 8) ? inp(IN_XP) + i * 8 : inp(IN_XS) + (i * 8 - (size_t)TP * D);
                a[r] = *(const f32x4*)src; b[r] = *(const f32x4*)(src + 4); }
#pragma unroll
            for (int r = 0; r < 4; ++r) { const size_t i = i0 + r * ngt;
                if (i < (size_t)T * D / 8) {
                    v4u w; w.x = pk2(a[r][0], a[r][1]); w.y = pk2(a[r][2], a[r][3]); w.z = pk2(b[r][0], b[r][1]); w.w = pk2(b[r][2], b[r][3]);
                    *(v4u*)(hb + i * 8) = w;
                } }
        }
    }
    {
        bf16* wsb = (bf16*)(ws + WS_WSB);
        for (size_t i = gt; i < (size_t)2 * 2 * 8 * 128 * 128; i += ngt) {
            const int s = (int)(i & 127), t = (int)((i >> 7) & 127), g = (int)((i >> 14) & 7), var = (int)((i >> 17) & 1), l = (int)(i >> 18);
            const float* w = inp(IN_WS) + ((size_t)(l * 8 + g) * 128) * 128;
            float v;
            if (var == 0) v = (s <= t) ? w[t * 128 + s] : 0.f;
            else v = ((t >> 3) == (s >> 3) && (s & 7) <= (t & 7)) ? w[(t & 7) * 128 + (s & 7)] : 0.f;
            wsb[i] = (bf16)f2bf(v);
        }
    }
    for (size_t i = gt; i < (size_t)128 * 120 * 128 / 4; i += ngt) {
        const size_t e = i * 4, db = e / (120 * 128), rem = e % (120 * 128);
        *(f32x4*)(F.out + O_KS + db * 128 * 128 + rem) = *(const f32x4*)(inp(IN_CK) + db * 128 * 128 + 8 * 128 + rem);
        *(f32x4*)(F.out + O_VS + db * 128 * 128 + rem) = *(const f32x4*)(inp(IN_CV) + db * 128 * 128 + 8 * 128 + rem);
    }
}

__device__ __forceinline__ void phase_spatial(Frame& F, int layer) {
    unsigned char* ws = F.ws;
    const bf16* Z = (const bf16*)(ws + WS_Z);
    const float* stats = (const float*)(ws + WS_STATS);
    const float* lng = inp(IN_SLNG) + layer * DSGU; const float* lnb = inp(IN_SLNB) + layer * DSGU;
    const float* bs = inp(IN_BS) + layer * 8 * 128;
    const bf16* wsb = (const bf16*)(ws + WS_WSB) + (size_t)layer * 2 * 8 * 128 * 128;
    bf16* gated = (bf16*)(ws + WS_GATED);
    float* osgu = F.out + O_SGU + (size_t)layer * TS * DSGU;
    constexpr int VS = 576, WSS = 272;
    LAS unsigned char* Wl = F.lds + 128 * VS + 1024;
    LAS f32x2* sttab = (LAS f32x2*)(F.lds + 128 * VS);
    const int lane = F.lane, w = F.wave, fr = lane & 15, fq = lane >> 4, q4 = (lane & 15) >> 2, p4 = lane & 3;
    int wvar = -1;
    for (int unit = F.bx; unit < 136 * 8; unit += F.G) {
        const int mt = unit >> 3, g = unit & 7, tok0 = mt * 128; const bool samp = mt >= 128;
        f32x4 pr[4];
#pragma unroll
        for (int k = 0; k < 4; ++k) pr[k] = *(const f32x4*)(stats + (size_t)(tok0 + (F.tid >> 2)) * 64 + (F.tid & 3) * 16 + 4 * k);
        v4u raw[8];
#pragma unroll
        for (int i = 0; i < 8; ++i) { const int id = F.tid + 512 * i, s = id >> 5, ch = id & 31; raw[i] = *(const v4u*)(Z + (size_t)(tok0 + s) * 4096 + 2048 + g * 256 + ch * 8); }
        v4u uu[8];
#pragma unroll
        for (int tt = 0; tt < 8; ++tt) uu[tt] = *(const v4u*)(Z + (size_t)(tok0 + 16 * tt + fr) * 4096 + g * 256 + 32 * w + 8 * fq);
        if (wvar != (samp ? 8 : 0) + g) {
            wvar = (samp ? 8 : 0) + g;
            const bf16* wg = wsb + ((size_t)wvar * 128) * 128;
#pragma unroll
            for (int i = 0; i < 4; ++i) { const int id = F.tid + 512 * i, r = id >> 4, ch = id & 15; *(LAS v4u*)(Wl + r * WSS + ch * 16) = *(const v4u*)(wg + (size_t)r * 128 + ch * 8); }
        }
        {
            float s1 = 0.f, s2 = 0.f;
#pragma unroll
            for (int k = 0; k < 4; ++k) { s1 += pr[k][0]; s2 += pr[k][1]; s1 += pr[k][2]; s2 += pr[k][3]; }
            s1 += __builtin_bit_cast(float, __builtin_amdgcn_update_dpp(0, __builtin_bit_cast(int, s1), 0xB1, 0xF, 0xF, true));
            s2 += __builtin_bit_cast(float, __builtin_amdgcn_update_dpp(0, __builtin_bit_cast(int, s2), 0xB1, 0xF, 0xF, true));
            s1 += __builtin_bit_cast(float, __builtin_amdgcn_update_dpp(0, __builtin_bit_cast(int, s1), 0x4E, 0xF, 0xF, true));
            s2 += __builtin_bit_cast(float, __builtin_amdgcn_update_dpp(0, __builtin_bit_cast(int, s2), 0x4E, 0xF, 0xF, true));
            const float mean = s1 * (1.f / DSGU), var = fmaxf(s2 * (1.f / DSGU) - mean * mean, 0.f);
            if ((F.tid & 3) == 0) sttab[F.tid >> 2] = (f32x2){mean, __builtin_amdgcn_rsqf(var + LN_EPS)};
        }
        __syncthreads();
#pragma unroll
        for (int i = 0; i < 8; ++i) {
            const int id = F.tid + 512 * i, s = id >> 5, ch = id & 31, tok = tok0 + s, col = g * 256 + ch * 8;
            const f32x2 st = sttab[s];
            const float mean = st.x, rstd = st.y;
            const f32x4 g0 = *(const f32x4*)(lng + col), g1 = *(const f32x4*)(lng + col + 4), b0 = *(const f32x4*)(lnb + col), b1 = *(const f32x4*)(lnb + col + 4);
            f32x4 y0, y1;
            y0[0] = (bflo(raw[i].x) - mean) * rstd * g0[0] + b0[0]; y0[1] = (bfhi(raw[i].x) - mean) * rstd * g0[1] + b0[1];
            y0[2] = (bflo(raw[i].y) - mean) * rstd * g0[2] + b0[2]; y0[3] = (bfhi(raw[i].y) - mean) * rstd * g0[3] + b0[3];
            y1[0] = (bflo(raw[i].z) - mean) * rstd * g1[0] + b1[0]; y1[1] = (bfhi(raw[i].z) - mean) * rstd * g1[1] + b1[1];
            y1[2] = (bflo(raw[i].w) - mean) * rstd * g1[2] + b1[2]; y1[3] = (bfhi(raw[i].w) - mean) * rstd * g1[3] + b1[3];
            v4u o; o.x = pk2(y0[0], y0[1]); o.y = pk2(y0[2], y0[3]); o.z = pk2(y1[0], y1[1]); o.w = pk2(y1[2], y1[3]);
            *(LAS v4u*)(F.lds + s * VS + ch * 16) = o;
            if (samp) { float* op = osgu + (size_t)(tok - TP) * DSGU + col; *(f32x4*)op = y0; *(f32x4*)(op + 4) = y1; }
        }
        __syncthreads();
        f32x4 acc[8][2];
#pragma unroll
        for (int tt = 0; tt < 8; ++tt) { acc[tt][0] = (f32x4){0.f, 0.f, 0.f, 0.f}; acc[tt][1] = (f32x4){0.f, 0.f, 0.f, 0.f}; }
        const unsigned vbase = (unsigned)(uintptr_t)(F.lds) + (unsigned)((8 * fq + q4) * VS + (32 * w + 8 * p4) * 2);
#pragma unroll
        for (int ks = 0; ks < 4; ++ks) {
            s16x4 lo0, hi0, lo1, hi1;
            const unsigned a0 = vbase + ks * 32 * VS;
            asm volatile("ds_read_b64_tr_b16 %0, %4\n\tds_read_b64_tr_b16 %1, %4 offset:2304\n\tds_read_b64_tr_b16 %2, %4 offset:8\n\tds_read_b64_tr_b16 %3, %4 offset:2312\n\ts_waitcnt lgkmcnt(0)"
                         : "=&v"(lo0), "=&v"(hi0), "=&v"(lo1), "=&v"(hi1) : "v"(a0) : "memory");
            const bf16x8 vf0 = (bf16x8){lo0[0], lo0[1], lo0[2], lo0[3], hi0[0], hi0[1], hi0[2], hi0[3]};
            const bf16x8 vf1 = (bf16x8){lo1[0], lo1[1], lo1[2], lo1[3], hi1[0], hi1[1], hi1[2], hi1[3]};
#pragma unroll
            for (int tt = 0; tt < 8; ++tt) {
                if (16 * tt + 15 >= 32 * ks) {
                    const bf16x8 wf = *(const LAS bf16x8*)(Wl + (16 * tt + fr) * WSS + (32 * ks + 8 * fq) * 2);
                    acc[tt][0] = __builtin_amdgcn_mfma_f32_16x16x32_bf16(vf0, wf, acc[tt][0], 0, 0, 0);
                    acc[tt][1] = __builtin_amdgcn_mfma_f32_16x16x32_bf16(vf1, wf, acc[tt][1], 0, 0, 0);
                }
            }
        }
#pragma unroll
        for (int tt = 0; tt < 8; ++tt) {
            const int t = 16 * tt + fr, tok = tok0 + t;
            const float bias = bs[g * 128 + (samp ? (t & 7) : t)];
            const size_t col = (size_t)g * 256 + 32 * w + 8 * fq;
            v4u o;
            o.x = pk2(bflo(uu[tt].x) * (acc[tt][0][0] + bias), bfhi(uu[tt].x) * (acc[tt][0][1] + bias));
            o.y = pk2(bflo(uu[tt].y) * (acc[tt][0][2] + bias), bfhi(uu[tt].y) * (acc[tt][0][3] + bias));
            o.z = pk2(bflo(uu[tt].z) * (acc[tt][1][0] + bias), bfhi(uu[tt].z) * (acc[tt][1][1] + bias));
            o.w = pk2(bflo(uu[tt].w) * (acc[tt][1][2] + bias), bfhi(uu[tt].w) * (acc[tt][1][3] + bias));
            *(v4u*)(gated + (size_t)tok * DSGU + col) = o;
        }
        __syncthreads();
    }
}

__device__ __forceinline__ void phase_ln1(Frame& F, int layer, bf16* hb) {
    unsigned char* ws = F.ws;
    const bf16* pre = (const bf16*)(ws + WS_PRE);
    const float* gg = inp(IN_LN1G) + layer * D; const float* bb = inp(IN_LN1B) + layer * D;
    const int gw = F.bx * NWAVES + F.wave, NGW = F.G * NWAVES, lane = F.lane;
    f32x4 gv[4], bv[4];
#pragma unroll
    for (int j = 0; j < 4; ++j) { gv[j] = *(const f32x4*)(gg + 4 * lane + 256 * j); bv[j] = *(const f32x4*)(bb + 4 * lane + 256 * j); }
    for (int m0 = gw; m0 < T; m0 += 9 * NGW) {
        f32x4 v[9][4];
#pragma unroll
        for (int r = 0; r < 9; ++r) { const int m = (m0 + r * NGW < T) ? m0 + r * NGW : m0;
#pragma unroll
            for (int j = 0; j < 4; ++j) { const v2u pw = *(const v2u*)(pre + (size_t)m * D + 4 * lane + 256 * j); v[r][j] = (f32x4){bflo(pw.x), bfhi(pw.x), bflo(pw.y), bfhi(pw.y)}; } }
#pragma unroll
        for (int r = 0; r < 9; ++r) {
            const int m = m0 + r * NGW;
            float s = 0.f;
#pragma unroll
            for (int j = 0; j < 4; ++j) s += (v[r][j][0] + v[r][j][1]) + (v[r][j][2] + v[r][j][3]);
            const float mean = wave_sum(s) * (1.f / D); float s2 = 0.f;
#pragma unroll
            for (int j = 0; j < 4; ++j) { v[r][j] = v[r][j] - mean; s2 += (v[r][j][0] * v[r][j][0] + v[r][j][1] * v[r][j][1]) + (v[r][j][2] * v[r][j][2] + v[r][j][3] * v[r][j][3]); }
            const float rstd = __builtin_amdgcn_rsqf(wave_sum(s2) * (1.f / D) + LN_EPS);
            if (m < T) {
#pragma unroll
                for (int j = 0; j < 4; ++j) {
                    const f32x4 y = v[r][j] * rstd * gv[j] + bv[j];
                    v2u o; o.x = pk2(y[0], y[1]); o.y = pk2(y[2], y[3]);
                    *(v2u*)(hb + (size_t)m * D + 4 * lane + 256 * j) = o;
                }
            }
        }
    }
}

__device__ __forceinline__ unsigned f2key(float s) { const unsigned u = __builtin_bit_cast(unsigned, s); return (u & 0x80000000u) ? ~u : (u | 0x80000000u); }
__device__ __forceinline__ float key2f(unsigned k, unsigned mask) { const unsigned u = (k & 0x80000000u) ? (k & 0x7fffffffu) : ~k; return __builtin_bit_cast(float, u & ~mask); }
__device__ __forceinline__ void ce_desc(unsigned& x, unsigned& y) { const unsigned hi = x > y ? x : y, lo = x > y ? y : x; x = hi; y = lo; }
__device__ __forceinline__ void sort16(unsigned (&a)[16]) {
#pragma unroll
    for (int k = 2; k <= 16; k <<= 1)
#pragma unroll
        for (int j = k >> 1; j > 0; j >>= 1)
#pragma unroll
            for (int i = 0; i < 16; ++i) { const int l = i ^ j; if (l > i) { if ((i & k) == 0) ce_desc(a[i], a[l]); else ce_desc(a[l], a[i]); } }
}
__device__ __forceinline__ void merge16(unsigned (&top)[16], const unsigned (&g)[16]) {
#pragma unroll
    for (int i = 0; i < 16; ++i) top[i] = top[i] > g[15 - i] ? top[i] : g[15 - i];
#pragma unroll
    for (int j = 8; j > 0; j >>= 1)
#pragma unroll
        for (int i = 0; i < 16; ++i) { const int l = i ^ j; if (l > i) ce_desc(top[i], top[l]); }
}
__device__ __forceinline__ void top16_of_128(const unsigned* sp, int p, unsigned (&top)[16]) {
    unsigned nx[16];
#pragma unroll
    for (int i = 0; i < 16; ++i) nx[i] = sp[(size_t)i * T];
#pragma unroll 1
    for (int grp = 0; grp < 8; ++grp) {
        unsigned g[16];
#pragma unroll
        for (int i = 0; i < 16; ++i) g[i] = (f2key(p ? bfhi(nx[i]) : bflo(nx[i])) & ~127u) | (unsigned)(127 - (grp * 16 + i));
        if (grp < 7) {
#pragma unroll
            for (int i = 0; i < 16; ++i) nx[i] = sp[(size_t)((grp + 1) * 16 + i) * T];
        }
        sort16(g);
        if (grp == 0) {
#pragma unroll
            for (int i = 0; i < 16; ++i) top[i] = g[i];
        } else merge16(top, g);
    }
}
__device__ __forceinline__ void top16x2_of_128(const unsigned* sp, unsigned (&t1)[16], unsigned (&t2)[16]) {
    unsigned nx[16];
#pragma unroll
    for (int i = 0; i < 16; ++i) nx[i] = sp[(size_t)i * T];
#pragma unroll 1
    for (int grp = 0; grp < 8; ++grp) {
        unsigned g1[16], g2[16];
#pragma unroll
        for (int i = 0; i < 16; ++i) { const unsigned ix = (unsigned)(127 - (grp * 16 + i)); g1[i] = (f2key(bflo(nx[i])) & ~127u) | ix; g2[i] = (f2key(bfhi(nx[i])) & ~127u) | ix; }
        if (grp < 7) {
#pragma unroll
            for (int i = 0; i < 16; ++i) nx[i] = sp[(size_t)((grp + 1) * 16 + i) * T];
        }
        sort16(g1); sort16(g2);
        if (grp == 0) {
#pragma unroll
            for (int i = 0; i < 16; ++i) { t1[i] = g1[i]; t2[i] = g2[i]; }
        } else { merge16(t1, g1); merge16(t2, g2); }
    }
}
__device__ __forceinline__ void phase_topk(Frame& F) {
    unsigned char* ws = F.ws;
    const unsigned* SC = (const unsigned*)(ws + WS_SC);
    int* eidx = (int*)(ws + WS_EIDX); float* gwt = (float*)(ws + WS_GW);
    LAS unsigned char* ib = F.lds + F.tid * 32;
    const int tpb = (T + F.G - 1) / F.G, t0 = F.bx * tpb, cnt = (T - t0) < tpb ? (T - t0 > 0 ? T - t0 : 0) : tpb;
    const int nit = cnt * 8, left = nit > 512 ? nit - 512 : 0;
    const bool pairs = left > 0 && left <= 256;
    for (int rnd = 0; rnd < 2; ++rnd) {
        int it; bool act, wr; int pp = 0;
        if (rnd == 0) { it = F.tid; act = it < nit; wr = act; }
        else if (pairs) { it = 512 + (F.tid >> 1); pp = F.tid & 1; act = (F.tid >> 1) < left; wr = act && pp == 0; }
        else { it = 512 + F.tid; act = it < nit; wr = act; }
        if (rnd == 1 && left == 0) break;
        if (__builtin_amdgcn_readfirstlane(__ballot(act) == 0ull ? 1 : 0)) continue;
        const int itc = act ? it : 0;
        const int h = itc / cnt, t = t0 + itc % cnt;
        unsigned l1[16], l2[16];
        if (rnd == 1 && pairs) {
            top16_of_128(SC + (size_t)(h * 128) * T + t, pp, l1);
#pragma unroll
            for (int i = 0; i < 16; ++i) l2[i] = (unsigned)__builtin_amdgcn_update_dpp(0, (int)l1[i], 0xB1, 0xF, 0xF, true);
            if (pp) {
#pragma unroll
                for (int i = 0; i < 16; ++i) { const unsigned x = l1[i]; l1[i] = l2[i]; l2[i] = x; }
            }
        } else {
            top16x2_of_128(SC + (size_t)(h * 128) * T + t, l1, l2);
        }
        float v1[16], v2[16];
#pragma unroll
        for (int i = 0; i < 16; ++i) { v1[i] = key2f(l1[i], 127u); v2[i] = key2f(l2[i], 127u); ib[i] = (unsigned char)(127u - (l1[i] & 127u)); ib[16 + i] = (unsigned char)(127u - (l2[i] & 127u)); }
        unsigned c[4][16];
        {
            int k = 0;
#pragma unroll
            for (int a = 0; a < 16; ++a)
#pragma unroll
                for (int b = 0; b < 16; ++b)
                    if ((a + 1) * (b + 1) <= 16) { c[k >> 4][k & 15] = (f2key(v1[a] + v2[b]) & ~255u) | (unsigned)(255 - (16 * a + b)); ++k; }
#pragma unroll
            for (; k < 64; ++k) c[k >> 4][k & 15] = 0u;
        }
        sort16(c[0]); sort16(c[1]); sort16(c[2]); sort16(c[3]);
        merge16(c[0], c[1]); merge16(c[0], c[2]); merge16(c[0], c[3]);
        float e[16], sum = 0.f; const float mx = key2f(c[0][0], 255u);
#pragma unroll
        for (int i = 0; i < 16; ++i) { e[i] = fexp2((key2f(c[0][i], 255u) - mx) * 1.4426950408889634f); sum += e[i]; }
        const float inv = 1.0f / sum;
        int* eo = eidx + (size_t)t * 128 + h * 16; float* go = gwt + (size_t)t * 128 + h * 16;
        LDS_WAIT();
#pragma unroll
        for (int i = 0; i < 16; ++i) {
            const unsigned ab = 255u - (c[0][i] & 255u);
            const int i1 = ib[ab >> 4], i2 = ib[16 + (ab & 15u)];
            if (wr) { eo[i] = i1 * 128 + i2; go[i] = e[i] * inv; }
        }
        LDS_WAIT();
    }
}

constexpr float PU_SCALE = 64.f, PV_SCALE = 16.f, Y_AK = 4.f;
typedef _Float16 h2v __attribute__((ext_vector_type(2)));
constexpr int G_NR = 64, G_SH = 8;
typedef unsigned u2v __attribute__((ext_vector_type(2)));
__device__ __forceinline__ float reduce4(float p0, float p1, float p2, float p3) {
    const u2v r01 = __builtin_amdgcn_permlane32_swap(__builtin_bit_cast(unsigned, p0), __builtin_bit_cast(unsigned, p1), false, false);
    const u2v r23 = __builtin_amdgcn_permlane32_swap(__builtin_bit_cast(unsigned, p2), __builtin_bit_cast(unsigned, p3), false, false);
    const unsigned a0 = r01.x, a1 = r01.y, b0 = r23.x, b1 = r23.y;
    const float s01 = __builtin_bit_cast(float, a0) + __builtin_bit_cast(float, a1), s23 = __builtin_bit_cast(float, b0) + __builtin_bit_cast(float, b1);
    const u2v q = __builtin_amdgcn_permlane16_swap(__builtin_bit_cast(unsigned, s01), __builtin_bit_cast(unsigned, s23), false, false);
    const unsigned q0 = q.x, q1 = q.y;
    return row16_sum(__builtin_bit_cast(float, q0) + __builtin_bit_cast(float, q1));
}
__device__ __forceinline__ void gsort2(unsigned& ka0, unsigned& kb0, unsigned& ka1, unsigned& kb1, int lane) {
#pragma unroll
    for (int k = 2; k <= 128; k <<= 1)
#pragma unroll
        for (int j = k >> 1; j > 0; j >>= 1)
#pragma unroll
            for (int s = 0; s < 2; ++s) {
                unsigned& ka = s ? ka1 : ka0; unsigned& kb = s ? kb1 : kb0;
                if (j == 64) { const unsigned lo = ka < kb ? ka : kb, hi = ka < kb ? kb : ka; ka = lo; kb = hi; }
                else {
                    const unsigned pa = (unsigned)__builtin_amdgcn_ds_bpermute((lane ^ j) << 2, (int)ka), pb = (unsigned)__builtin_amdgcn_ds_bpermute((lane ^ j) << 2, (int)kb);
                    const bool lower = (lane & j) == 0;
                    const bool upa = (k >= 128) ? true : ((lane & k) == 0);
                    const bool upb = (k >= 128) ? true : ((k == 64) ? false : ((lane & k) == 0));
                    const unsigned mna = ka < pa ? ka : pa, mxa = ka < pa ? pa : ka;
                    const unsigned mnb = kb < pb ? kb : pb, mxb = kb < pb ? pb : kb;
                    ka = (upa == lower) ? mna : mxa; kb = (upb == lower) ? mnb : mxb;
                }
            }
}
__device__ __forceinline__ void gsort4(unsigned (&ka_)[4], unsigned (&kb_)[4], int lane) {
#pragma unroll
    for (int k = 2; k <= 128; k <<= 1)
#pragma unroll
        for (int j = k >> 1; j > 0; j >>= 1) {
            if (j == 64) {
#pragma unroll
                for (int s = 0; s < 4; ++s) { const unsigned lo = ka_[s] < kb_[s] ? ka_[s] : kb_[s], hi = ka_[s] < kb_[s] ? kb_[s] : ka_[s]; ka_[s] = lo; kb_[s] = hi; }
            } else {
                unsigned pa[4], pb[4];
#pragma unroll
                for (int s = 0; s < 4; ++s) { pa[s] = (unsigned)__builtin_amdgcn_ds_bpermute((lane ^ j) << 2, (int)ka_[s]); pb[s] = (unsigned)__builtin_amdgcn_ds_bpermute((lane ^ j) << 2, (int)kb_[s]); }
                const bool lower = (lane & j) == 0;
                const bool upa = (k >= 128) ? true : ((lane & k) == 0);
                const bool upb = (k >= 128) ? true : ((k == 64) ? false : ((lane & k) == 0));
#pragma unroll
                for (int s = 0; s < 4; ++s) {
                    const unsigned mna = ka_[s] < pa[s] ? ka_[s] : pa[s], mxa = ka_[s] < pa[s] ? pa[s] : ka_[s];
                    const unsigned mnb = kb_[s] < pb[s] ? kb_[s] : pb[s], mxb = kb_[s] < pb[s] ? pb[s] : kb_[s];
                    ka_[s] = (upa == lower) ? mna : mxa; kb_[s] = (upb == lower) ? mnb : mxb;
                }
            }
        }
}
constexpr int GNS = 4;
__device__ __forceinline__ void phase_gather(Frame& F, int layer, bf16* hb, bool dry = false) {
    unsigned char* ws = F.ws;
    const int* eidx = (const int*)(ws + WS_EIDX); const float* gwt = (const float*)(ws + WS_GW);
    const float* g2 = inp(IN_LN2G) + layer * D; const float* b2 = inp(IN_LN2B) + layer * D;
    const int tpb = (T + F.G - 1) / F.G, t0 = F.bx * tpb, cnt = (T - t0) < tpb ? (T - t0 > 0 ? T - t0 : 0) : tpb;
    const int lane = F.lane;
    const __amdgpu_buffer_rsrc_t srdU = __builtin_amdgcn_make_buffer_rsrc((void*)(ws + WS_PU + (size_t)layer * NEXP * D), (short)0, NEXP * D, 0x00020000);
    const __amdgpu_buffer_rsrc_t srdV = __builtin_amdgcn_make_buffer_rsrc((void*)(ws + WS_PV + (size_t)layer * NEXP * D), (short)0, NEXP * D, 0x00020000);
    const unsigned l16 = (unsigned)lane * 16u;
    const bool dg = (lane >> 4) == ((lane & 15) >> 2);
    const int ridx = (int)(reduce4(1.f / 64.f, 2.f / 64.f, 3.f / 64.f, 4.f / 64.f) + 0.5f) - 1;
    const int pos0 = __builtin_ctzll(__ballot(ridx == 0)), pos1 = __builtin_ctzll(__ballot(ridx == 1)), pos2 = __builtin_ctzll(__ballot(ridx == 2)), pos3 = __builtin_ctzll(__ballot(ridx == 3));
    const int npass = ((cnt + NWAVES - 1) / NWAVES + GNS - 1) / GNS;
#pragma unroll 1
    for (int pass = 0; pass < npass; ++pass) {
        long xq[GNS][2]; h2v yh[GNS][8];
        unsigned ka[GNS], kb[GNS]; float ga[GNS], gb[GNS]; int tk[GNS];
        int nv = 0;
#pragma unroll
        for (int s = 0; s < GNS; ++s) {
            const int tt = F.wave + NWAVES * (GNS * pass + s);
            const bool ok = tt < cnt; const int t = ok ? t0 + tt : t0;
            tk[s] = ok ? t : -1; nv += ok ? 1 : 0;
            {
                const v4u x0 = *(const v4u*)(hb + (size_t)t * D + lane * 16), x1 = *(const v4u*)(hb + (size_t)t * D + lane * 16 + 8);
                int q0 = __builtin_amdgcn_cvt_pk_fp8_f32(bflo(x0.x), bfhi(x0.x), 0, false); q0 = __builtin_amdgcn_cvt_pk_fp8_f32(bflo(x0.y), bfhi(x0.y), q0, true);
                int q1 = __builtin_amdgcn_cvt_pk_fp8_f32(bflo(x0.z), bfhi(x0.z), 0, false); q1 = __builtin_amdgcn_cvt_pk_fp8_f32(bflo(x0.w), bfhi(x0.w), q1, true);
                int q2 = __builtin_amdgcn_cvt_pk_fp8_f32(bflo(x1.x), bfhi(x1.x), 0, false); q2 = __builtin_amdgcn_cvt_pk_fp8_f32(bflo(x1.y), bfhi(x1.y), q2, true);
                int q3 = __builtin_amdgcn_cvt_pk_fp8_f32(bflo(x1.z), bfhi(x1.z), 0, false); q3 = __builtin_amdgcn_cvt_pk_fp8_f32(bflo(x1.w), bfhi(x1.w), q3, true);
                xq[s][0] = (long)(((unsigned long long)(unsigned)q1 << 32) | (unsigned)q0); xq[s][1] = (long)(((unsigned long long)(unsigned)q3 << 32) | (unsigned)q2);
#pragma unroll
                for (int p = 0; p < 8; ++p) yh[s][p] = (h2v){(_Float16)0.f, (_Float16)0.f};
            }
            ka[s] = ((unsigned)eidx[(size_t)t * 128 + lane] << 7) | (unsigned)lane;
            kb[s] = ((unsigned)eidx[(size_t)t * 128 + 64 + lane] << 7) | (unsigned)(64 + lane);
            ga[s] = gwt[(size_t)t * 128 + lane]; gb[s] = gwt[(size_t)t * 128 + 64 + lane];
        }
        nv = __builtin_amdgcn_readfirstlane(nv);
        if (nv > 2) gsort4(ka, kb, lane); else if (nv > 0) gsort2(ka[0], kb[0], ka[1], kb[1], lane);
#pragma unroll
        for (int z = 0; z < GNS; ++z) {
            if (z < nv) {
                const int ja = (int)(ka[z] & 127u), jb = (int)(kb[z] & 127u);
                const float a0 = bperm(ja & 63, ga[z]), a1 = bperm(ja & 63, gb[z]), b0 = bperm(jb & 63, ga[z]), b1 = bperm(jb & 63, gb[z]);
                ga[z] = (ja & 64) ? a1 : a0; gb[z] = (jb & 64) ? b1 : b0;
            }
        }
        v4u uA[4], vA[4], uB[4], vB[4];
#define G_FILL4(s, X, st) do { _Pragma("unroll") for (int i_ = 0; i_ < 4; ++i_) { \
            const int e_ = __builtin_amdgcn_readlane((int)ka[s], 4 * (st) + i_) >> 7; \
            u##X[i_] = __builtin_amdgcn_raw_buffer_load_b128(srdU, (int)l16, e_ * D, 0); v##X[i_] = __builtin_amdgcn_raw_buffer_load_b128(srdV, (int)l16, e_ * D, 0); } } while (0)
#define G_CVH(W, HI) __builtin_bit_cast(h2v, __builtin_amdgcn_cvt_scalef32_pk_f16_fp8((W), 1.0f, (HI)))
#define G_STEP4(s, X, st) do { float pt_[4]; f32x4 ac_[4]; \
              \
            _Pragma("unroll") for (int i_ = 0; i_ < 4; ++i_) { \
                ac_[i_] = __builtin_amdgcn_mfma_f32_16x16x32_fp8_fp8((long)(((unsigned long long)u##X[i_][1] << 32) | u##X[i_][0]), xq[s][0], (f32x4){0.f, 0.f, 0.f, 0.f}, 0, 0, 0); \
                ac_[i_] = __builtin_amdgcn_mfma_f32_16x16x32_fp8_fp8((long)(((unsigned long long)u##X[i_][3] << 32) | u##X[i_][2]), xq[s][1], ac_[i_], 0, 0, 0); } \
            const float gv_ = bperm(4 * (st) + ridx, ga[s]);               \
            _Pragma("unroll") for (int i_ = 0; i_ < 4; ++i_) { \
                const float dv_ = (lane & 2) ? ((lane & 1) ? ac_[i_][3] : ac_[i_][2]) : ((lane & 1) ? ac_[i_][1] : ac_[i_][0]);     \
                pt_[i_] = dg ? dv_ : 0.f; } \
            const float tw_ = reduce4(pt_[0], pt_[1], pt_[2], pt_[3]);     \
            const _Float16 ah_ = (_Float16)(gelu_tanh(tw_ * (1.f / PU_SCALE)) * gv_ * Y_AK);     \
            const h2v ap_ = {ah_, ah_}; const int av_ = __builtin_bit_cast(int, ap_); \
            _Pragma("unroll") for (int i_ = 0; i_ < 4; ++i_) { \
                const h2v a2_ = __builtin_bit_cast(h2v, __builtin_amdgcn_readlane(av_, i_ == 0 ? pos0 : i_ == 1 ? pos1 : i_ == 2 ? pos2 : pos3)); \
                _Pragma("unroll") for (int w_ = 0; w_ < 4; ++w_) { \
                    yh[s][2 * w_] = __builtin_elementwise_fma(G_CVH(v##X[i_][w_], false), a2_, yh[s][2 * w_]); \
                    yh[s][2 * w_ + 1] = __builtin_elementwise_fma(G_CVH(v##X[i_][w_], true), a2_, yh[s][2 * w_ + 1]); } } } while (0)
#define G_SYNC(it) do { if ((it) && !((it) & 3)) __syncthreads(); } while (0)
#pragma unroll 1
        for (int half = 0; half < 2; ++half) {
            __syncthreads();
            if (nv == 4) {
                G_FILL4(0, A, 0);
#pragma unroll 1
                for (int it = 0; it < 16; ++it) {
                    G_SYNC(it);
                    G_FILL4(1, B, it); G_STEP4(0, A, it);
                    G_FILL4(2, A, it); G_STEP4(1, B, it);
                    G_FILL4(3, B, it); G_STEP4(2, A, it);
                    if (it < 15) G_FILL4(0, A, it + 1);
                    G_STEP4(3, B, it);
                }
            } else if (nv == 1) {
                G_FILL4(0, A, 0);
#pragma unroll 1
                for (int it = 0; it < 16; it += 2) {
                    G_SYNC(it);
                    G_FILL4(0, B, it + 1); G_STEP4(0, A, it);
                    if (it < 14) G_FILL4(0, A, it + 2);
                    G_STEP4(0, B, it + 1);
                }
            } else {
#define G_SLOW(s) if ((s) < nv) { _Pragma("unroll 1") for (int it = 0; it < 16; ++it) { G_FILL4(s, A, it); G_STEP4(s, A, it); } }
                G_SLOW(0) G_SLOW(1) G_SLOW(2) G_SLOW(3)
#undef G_SLOW
                __syncthreads(); __syncthreads(); __syncthreads();
            }
#pragma unroll
            for (int s = 0; s < GNS; ++s) { ka[s] = kb[s]; ga[s] = gb[s]; }
        }
#undef G_FILL4
#undef G_STEP4
#undef G_CVH
#undef G_SYNC
        f32x4 g2q[4], b2q[4];
#pragma unroll
        for (int c = 0; c < 4; ++c) { g2q[c] = *(const f32x4*)(g2 + lane * 16 + 4 * c); b2q[c] = *(const f32x4*)(b2 + lane * 16 + 4 * c); }
#pragma unroll
        for (int s = 0; s < GNS; ++s) {
            float sm = 0.f; f32x2 y[8];
            { const int tsafe = tk[s] >= 0 ? tk[s] : t0;
              const v4u x0 = *(const v4u*)(hb + (size_t)tsafe * D + lane * 16), x1 = *(const v4u*)(hb + (size_t)tsafe * D + lane * 16 + 8);
              const f32x2 xr[8] = {(f32x2){bflo(x0.x), bfhi(x0.x)}, (f32x2){bflo(x0.y), bfhi(x0.y)}, (f32x2){bflo(x0.z), bfhi(x0.z)}, (f32x2){bflo(x0.w), bfhi(x0.w)},
                                   (f32x2){bflo(x1.x), bfhi(x1.x)}, (f32x2){bflo(x1.y), bfhi(x1.y)}, (f32x2){bflo(x1.z), bfhi(x1.z)}, (f32x2){bflo(x1.w), bfhi(x1.w)}};
#pragma unroll
              for (int p = 0; p < 8; ++p) { y[p] = xr[p] * ALPHA + (f32x2){(float)yh[s][p].x, (float)yh[s][p].y} * (1.f / (PV_SCALE * Y_AK)); sm += y[p].x + y[p].y; } }
            const float mean = wave_sum(sm) * (1.f / D);
            float s2 = 0.f;
#pragma unroll
            for (int p = 0; p < 8; ++p) { y[p] = y[p] - mean; s2 += y[p].x * y[p].x + y[p].y * y[p].y; }
            const float rstd = __builtin_amdgcn_rsqf(wave_sum(s2) * (1.f / D) + LN_EPS);
            if (dry) asm volatile("" :: "v"(rstd));
            if (tk[s] >= 0 && !dry) {
                const size_t ro = (size_t)tk[s] * D + lane * 16;
                unsigned wb[8];
#pragma unroll
                for (int c = 0; c < 4; ++c) {
                    const f32x4 ga = g2q[c], ba = b2q[c];
                    f32x4 o;
                    o[0] = y[2 * c].x * rstd * ga[0] + ba[0]; o[1] = y[2 * c].y * rstd * ga[1] + ba[1];
                    o[2] = y[2 * c + 1].x * rstd * ga[2] + ba[2]; o[3] = y[2 * c + 1].y * rstd * ga[3] + ba[3];
                    wb[2 * c] = pk2(o[0], o[1]); wb[2 * c + 1] = pk2(o[2], o[3]);
                }
                *(v4u*)(hb + ro) = (v4u){wb[0], wb[1], wb[2], wb[3]}; *(v4u*)(hb + ro + 8) = (v4u){wb[4], wb[5], wb[6], wb[7]};
            }
        }
    }
}

__device__ __forceinline__ void phase_attn(Frame& F, int jl  ) {
    unsigned char* ws = F.ws;
    const bf16* qb = (const bf16*)(ws + WS_QB); const bf16* kvb = (const bf16*)(ws + WS_KVB); bf16* att = (bf16*)(ws + WS_ATT);
    const float* sinks = inp(IN_SINK) + jl * 16;
    constexpr int KS = 144, VSB = 192;
    LAS unsigned char* Kl = F.lds; LAS unsigned char* Vl = F.lds + 256 * KS;
    const int lane = F.lane, ql = lane & 31, hh2 = lane >> 5;
    for (int unit = F.bx; unit < 256; unit += F.G) {
        const int b = unit >> 7, n = (unit >> 1) & 63, kvh = unit & 1;
        const int tokb = b * 8192 + 128 * n;
#pragma unroll
        for (int i = 0; i < 4; ++i) {
            const int id = F.tid + 512 * i, row = id >> 3, ch = id & 7;
            const int tok = (row < 128) ? ((n > 0) ? tokb - 128 + row : tokb + row) : tokb + row - 128;
            const v4u kk = *(const v4u*)(kvb + (size_t)tok * 256 + kvh * 64 + ch * 8);
            const v4u vv = *(const v4u*)(kvb + (size_t)tok * 256 + 128 + kvh * 64 + ch * 8);
            *(LAS v4u*)(Kl + row * KS + ch * 16) = kk; *(LAS v4u*)(Vl + row * VSB + ch * 16) = vv;
        }
        __syncthreads();
        const int hd = kvh * 8 + F.wave;
        const float slope = fexp2(-0.5f * (float)(hd + 1)), sink = sinks[hd];
        const unsigned vlane = (unsigned)(uintptr_t)Vl + (unsigned)((4 * (lane >> 5) + ((lane & 15) >> 2)) * VSB + (16 * ((lane >> 4) & 1) + 4 * (lane & 3)) * 2);
        const GAS bf16* qg = (const GAS bf16*)qb; GAS bf16* ag = (GAS bf16*)att;
        bf16x8 qf[4];
#pragma unroll
        for (int s = 0; s < 4; ++s) qf[s] = *(const GAS bf16x8*)(qg + (size_t)(tokb + ql) * D + hd * 64 + 16 * s + 8 * hh2);
#pragma unroll 1
        for (int qs = 0; qs < 4; ++qs) {
            const int tq = tokb + 32 * qs + ql;
            bf16x8 qn[4];
            { const int tqn = tokb + 32 * (qs < 3 ? qs + 1 : qs) + ql;
#pragma unroll
              for (int s = 0; s < 4; ++s) qn[s] = *(const GAS bf16x8*)(qg + (size_t)tqn * D + hd * 64 + 16 * s + 8 * hh2); }
            f32x16 st[5];
#pragma unroll
            for (int t5 = 0; t5 < 5; ++t5) {
                f32x16 acc;
#pragma unroll
                for (int r = 0; r < 16; ++r) acc[r] = 0.f;
                const int kt = qs + t5;
#pragma unroll
                for (int s = 0; s < 4; ++s) {
                    const bf16x8 kf = *(const LAS bf16x8*)(Kl + (32 * kt + ql) * KS + (16 * s + 8 * hh2) * 2);
                    acc = __builtin_amdgcn_mfma_f32_32x32x16_bf16(kf, qf[s], acc, 0, 0, 0);
                }
                st[t5] = acc;
            }
            const int iq = 32 * qs + ql;
            float m = sink;
#pragma unroll
            for (int t5 = 0; t5 < 5; ++t5)
#pragma unroll
                for (int r = 0; r < 16; ++r) {
                    const int j = 32 * (qs + t5) + (r & 3) + 8 * (r >> 2) + 4 * hh2;
                    const int dist = iq + 128 - j;
                    const bool valid = (dist >= 0) && (dist < 128) && ((n > 0) || (j >= 128));
                    const float sv = valid ? st[t5][r] * 0.125f - slope * (float)dist : -INFINITY;
                    st[t5][r] = sv; m = fmaxf(m, sv);
                }
            m = fmaxf(m, bperm(lane ^ 32, m));
            float l = 0.f;
            v4u pw[5][2];
#pragma unroll
            for (int t5 = 0; t5 < 5; ++t5)
#pragma unroll
                for (int s2 = 0; s2 < 2; ++s2) {
                    float p[8];
#pragma unroll
                    for (int e = 0; e < 8; ++e) { p[e] = fexp2((st[t5][8 * s2 + e] - m) * 1.4426950408889634f); l += p[e]; }
                    pw[t5][s2] = (v4u){pk2(p[0], p[1]), pk2(p[2], p[3]), pk2(p[4], p[5]), pk2(p[6], p[7])};
                }
            l += bperm(lane ^ 32, l);
            l += fexp2((sink - m) * 1.4426950408889634f);
#if defined(DBG_NOATT)
            const float inv = 0.f / l;
#else
            const float inv = 1.0f / l;
#endif
            f32x16 o0, o1;
#pragma unroll
            for (int r = 0; r < 16; ++r) { o0[r] = 0.f; o1[r] = 0.f; }
#pragma unroll
            for (int t5 = 0; t5 < 5; ++t5) {
                const int kt = qs + t5;
#pragma unroll
                for (int s2 = 0; s2 < 2; ++s2) {
                    const bf16x8 pf = __builtin_bit_cast(bf16x8, pw[t5][s2]);
                    s16x4 a0, a1, c0, c1;
                    const unsigned va = vlane + (unsigned)((32 * kt + 16 * s2) * VSB);
                    asm volatile("ds_read_b64_tr_b16 %0, %4\n\tds_read_b64_tr_b16 %1, %4 offset:1536\n\tds_read_b64_tr_b16 %2, %4 offset:64\n\tds_read_b64_tr_b16 %3, %4 offset:1600\n\ts_waitcnt lgkmcnt(0)"
                                 : "=&v"(a0), "=&v"(a1), "=&v"(c0), "=&v"(c1) : "v"(va) : "memory");
                    const bf16x8 vf0 = (bf16x8){a0[0], a0[1], a0[2], a0[3], a1[0], a1[1], a1[2], a1[3]};
                    const bf16x8 vf1 = (bf16x8){c0[0], c0[1], c0[2], c0[3], c1[0], c1[1], c1[2], c1[3]};
                    o0 = __builtin_amdgcn_mfma_f32_32x32x16_bf16(vf0, pf, o0, 0, 0, 0);
                    o1 = __builtin_amdgcn_mfma_f32_32x32x16_bf16(vf1, pf, o1, 0, 0, 0);
                }
            }
            GAS bf16* op = ag + (size_t)tq * D + hd * 64 + 4 * hh2;
#pragma unroll
            for (int g4 = 0; g4 < 4; ++g4) {
                v2u w; w.x = pk2(o0[4 * g4 + 0] * inv, o0[4 * g4 + 1] * inv); w.y = pk2(o0[4 * g4 + 2] * inv, o0[4 * g4 + 3] * inv);
                *(GAS v2u*)(op + 8 * g4) = w;
                v2u x; x.x = pk2(o1[4 * g4 + 0] * inv, o1[4 * g4 + 1] * inv); x.y = pk2(o1[4 * g4 + 2] * inv, o1[4 * g4 + 3] * inv);
                *(GAS v2u*)(op + 32 + 8 * g4) = x;
            }
#pragma unroll
            for (int s = 0; s < 4; ++s) qf[s] = qn[s];
        }
        __syncthreads();
    }
    {
        const float* ck = inp(IN_CK); const float* cv = inp(IN_CV);
        constexpr int KSS = 68;
        LAS float* Ksm = (LAS float*)F.lds; LAS float* Vsm = (LAS float*)(F.lds + 136 * KSS * 4);
        for (int su = F.bx; su < 256; su += F.G) {
            const int db = su >> 1, kvh = su & 1;
            int tid_ = F.tid; asm volatile("" : "+v"(tid_));
            const int hd = kvh * 8 + F.wave;
            const float slope = fexp2(-0.5f * (float)(hd + 1)), sink = sinks[hd];
            LAS unsigned char* Ql = F.lds + 73728 + F.wave * 1024;
            const v4u qrow = *(const v4u*)(qb + (size_t)(TP + db * 8 + (lane >> 3)) * D + hd * 64 + (lane & 7) * 8);
            {
                f32x4 kq[4], vq[4]; v2u kw = {0u, 0u}, vw = {0u, 0u};
#pragma unroll
                for (int i = 0; i < 4; ++i) { const int id = tid_ + 512 * i, j = id >> 4, c4 = (id & 15) * 4;
                    kq[i] = *(const f32x4*)(ck + ((size_t)(db * 128 + j) * 2 + kvh) * 64 + c4); vq[i] = *(const f32x4*)(cv + ((size_t)(db * 128 + j) * 2 + kvh) * 64 + c4); }
                if (tid_ < 128) { const int j = 128 + (tid_ >> 4), c4 = (tid_ & 15) * 4;
                    kw = *(const v2u*)(kvb + (size_t)(TP + db * 8 + j - 128) * 256 + kvh * 64 + c4); vw = *(const v2u*)(kvb + (size_t)(TP + db * 8 + j - 128) * 256 + 128 + kvh * 64 + c4); }
#pragma unroll
                for (int i = 0; i < 4; ++i) { const int id = tid_ + 512 * i, j = id >> 4, c4 = (id & 15) * 4;
                    *(LAS f32x4*)(Ksm + j * KSS + c4) = kq[i]; *(LAS f32x4*)(Vsm + j * 64 + c4) = vq[i]; }
                if (tid_ < 128) { const int j = 128 + (tid_ >> 4), c4 = (tid_ & 15) * 4;
                    *(LAS f32x4*)(Ksm + j * KSS + c4) = (f32x4){bflo(kw.x), bfhi(kw.x), bflo(kw.y), bfhi(kw.y)}; *(LAS f32x4*)(Vsm + j * 64 + c4) = (f32x4){bflo(vw.x), bfhi(vw.x), bflo(vw.y), bfhi(vw.y)}; }
                *(LAS v4u*)(Ql + lane * 16) = qrow;
            }
            __syncthreads();
#pragma unroll 2
            for (int l = 0; l < 8; ++l) {
                const int tq = TP + db * 8 + l;
                v4u qv[8];
#pragma unroll
                for (int i = 0; i < 8; ++i) qv[i] = *(const LAS v4u*)(Ql + l * 128 + i * 16);
                float sc[3];
#pragma unroll
                for (int ps = 0; ps < 3; ++ps) {
                    const int jj = lane + 64 * ps, jr = jj < 136 ? jj : 135;
                    const LAS float* kr = Ksm + jr * KSS;
                    float dot = 0.f;
#pragma unroll
                    for (int i = 0; i < 8; ++i) {
                        const f32x4 k0 = *(const LAS f32x4*)(kr + i * 8), k1 = *(const LAS f32x4*)(kr + i * 8 + 4);
                        dot += bflo(qv[i].x) * k0[0] + bfhi(qv[i].x) * k0[1] + bflo(qv[i].y) * k0[2] + bfhi(qv[i].y) * k0[3]
                             + bflo(qv[i].z) * k1[0] + bfhi(qv[i].z) * k1[1] + bflo(qv[i].w) * k1[2] + bfhi(qv[i].w) * k1[3];
                    }
                    const int dist = l + 128 - jj;
                    const bool valid = (jj < 136) && (dist >= 0) && (dist < 128);
                    sc[ps] = valid ? dot * 0.125f - slope * (float)dist : -INFINITY;
                }
                const float m = fmaxf(wave_max(fmaxf(fmaxf(sc[0], sc[1]), sc[2])), sink);
                const float p0 = fexp2((sc[0] - m) * 1.4426950408889634f), p1 = fexp2((sc[1] - m) * 1.4426950408889634f), p2 = fexp2((sc[2] - m) * 1.4426950408889634f);
                const float lsum = wave_sum(p0 + p1 + p2) + fexp2((sink - m) * 1.4426950408889634f);
                float oa[4] = {0.f, 0.f, 0.f, 0.f};
                const int p0i = __builtin_bit_cast(int, p0), p1i = __builtin_bit_cast(int, p1), p2i = __builtin_bit_cast(int, p2);
#pragma unroll 4
                for (int jb = 0; jb < 64; jb += 4) {
#pragma unroll
                    for (int u = 0; u < 4; ++u) {
                        oa[u] += __builtin_bit_cast(float, __builtin_amdgcn_readlane(p0i, jb + u)) * Vsm[(jb + u) * 64 + lane];
                        oa[u] += __builtin_bit_cast(float, __builtin_amdgcn_readlane(p1i, jb + u)) * Vsm[(jb + u + 64) * 64 + lane];
                    }
                }
#pragma unroll
                for (int jj = 0; jj < 8; ++jj) oa[jj & 3] += __builtin_bit_cast(float, __builtin_amdgcn_readlane(p2i, jj)) * Vsm[(128 + jj) * 64 + lane];
                const float o = (oa[0] + oa[1]) + (oa[2] + oa[3]);
#if defined(DBG_NOATT)
                att[(size_t)tq * D + hd * 64 + lane] = (bf16)f2bf(0.f * o / lsum);
#else
                att[(size_t)tq * D + hd * 64 + lane] = (bf16)f2bf(o / lsum);
#endif
            }
            __syncthreads();
        }
    }
}

#ifndef PH_MASK
#define PH_MASK 0xFFFF
#endif
#define PHM(b) ((PH_MASK >> (b)) & 1)
#ifndef DBG_REP
#define DBG_REP 0
#endif

struct Args { const float* in[29]; float* out; unsigned char* ws; int ph_lo, ph_hi; };
__global__ void __launch_bounds__(NWAVES * 64, 2) yoco_fwd(Args args) {
    extern __shared__ __attribute__((aligned(16))) unsigned char lds_raw[];
    Frame F;
    F.lds = (LAS unsigned char*)lds_raw;
    F.MISC = (volatile LAS unsigned*)(F.lds + MISC_OFF);
    const int wave0 = __builtin_amdgcn_readfirstlane(threadIdx.x >> 6);
    F.tid = threadIdx.x; F.lane = F.tid & 63; F.wave = wave0;
    F.G = gridDim.x;
    F.out = args.out; F.ws = args.ws; F.ctl = (gu32*)(args.ws + WS_CTL);
    GAS unsigned char* wsg = (GAS unsigned char*)args.ws;
    unsigned char* ws = args.ws;
    for (int u = F.tid; u < (LDS_BYTES - LDSCTL_OFF) / 4; u += NWAVES * 64) ((LAS unsigned*)(F.lds + LDSCTL_OFF))[u] = 0u;
    __syncthreads();
    XcdBarrier bar; bar.bar = (unsigned*)(F.ctl + CW_BAR); bar.x = 0; bar.st = nullptr;
    if (MK_N_LAUNCHES == 1) bar = xcd_barrier_post((unsigned*)(F.ctl + CW_BAR), F.MISC + 8);

    for (int it = 2 * args.ph_lo; it < 2 * args.ph_hi; ++it) {
        const int ph = it >> 1;
        int cls = (ph < 2) ? ph + 8 : ((ph - 2) & 7);
        if (cls == 1 && ph >= 18) cls = 10;
        const bool twice = ((DBG_REP >> cls) & 1) != 0;
        if (!(it & 1) && !twice) continue;
        const bool dry = !(it & 1);
#define FRESH() do { int l_; asm volatile("v_mbcnt_lo_u32_b32 %0, -1, 0\n\tv_mbcnt_hi_u32_b32 %0, -1, %0" : "=v"(l_)); F.lane = l_; F.wave = wave0; F.tid = wave0 * 64 + l_; } while (0)
        unsigned char* wsf = args.ws; asm volatile("" : "+s"(wsf));
        asm volatile("" : "+s"(wsg)); ws = (unsigned char*)wsg; F.ws = ws;
        int bx = blockIdx.x, gx = gridDim.x; asm volatile("" : "+s"(bx), "+s"(gx)); F.G = gx; F.bx = bx;
        if (ph == 0) {
            FRESH(); if (PHM(0)) phase_prologue(F);
        } else if (ph == 1) {
            FRESH();
            if (PHM(2)) {
                pg8::Gemm g2{(const bf16*)(ws + WS_PBF), (const bf16*)(ws + WS_PLE), 4 * T, 1024, 256};
                pg8::StaticOrder S2; S2.init(4 * T, 1024, F.G, (bx + 192) % F.G, T / 256);
                EpiBf E2{(bf16*)(ws + WS_PP), 1024};
                pg8::gemm_phase<EpiBf, pg8::StaticOrder, true, true>(F.lds, g2, S2, E2, F.tid);
            }
        } else {
            const int qq = ph - 2, layer = qq >> 3, sub = qq & 7;
            bf16* HBc = (bf16*)(ws + ((layer & 1) ? WS_HB2 : WS_HB));
            bf16* HBn = (bf16*)(ws + ((layer & 1) ? WS_HB : WS_HB2));
            if (sub == 0) {
                FRESH();
                if (!PHM(1)) {} else if (layer < 2) {
                    pg8::Gemm g{HBc, (const bf16*)(ws + WS_WIN) + (size_t)layer * 4096 * 1024, T, 4096, 1024};
                    pg8::StaticOrder S; S.init(T, 4096, F.G, bx);
                    EpiZ E{(bf16*)(ws + WS_Z), inp(IN_BIN) + layer * 4096, (float*)(ws + WS_STATS)};
                    pg8::gemm_phase<EpiZ, pg8::StaticOrder, true, true>(F.lds, g, S, E, F.tid);
                    FRESH(); table_filler(F, layer, 0, (T / 256) * 16);
                } else if (PHM(3)) {
                    const bool first = (layer == 2);
                    pg8::Gemm g{HBc, (const bf16*)(ws + (first ? WS_WQKV : WS_WQ1)), first ? T : TP, first ? 1280 : 1024, 1024};
                    pg8::StaticOrder S; S.init(first ? T : TP, first ? 1280 : 1024, F.G, bx);
                    EpiQKV E{(bf16*)(ws + WS_QB), (bf16*)(ws + WS_KVB), F.out};
                    pg8::gemm_phase<EpiQKV, pg8::StaticOrder, true, true>(F.lds, g, S, E, F.tid);
                    FRESH();
                    if (!first) sgemm64(F, g.A, g.Bt, TP, TS / 64, 16, g.K, E);
                    if (first) table_filler(F, layer, 0, (T / 256) * 5);
                }
            } else if (sub == 1) {
                FRESH();
                if (layer < 2) { if (PHM(4)) phase_spatial(F, layer); } else { F.ws = wsf; if (PHM(5)) phase_attn(F, layer - 2); }
            } else if (sub == 2 && PHM(6)) {
                FRESH();
                const bool isa = layer < 2;
                pg8::Gemm g{isa ? (const bf16*)(ws + WS_GATED) : (const bf16*)(ws + WS_ATT),
                            isa ? (const bf16*)(ws + WS_WOUT) + (size_t)layer * 1024 * 2048 : (const bf16*)(ws + WS_WO) + (size_t)(layer - 2) * 1024 * 1024, TP, 1024, isa ? 2048 : 1024};
                pg8::StaticOrder S; S.init(TP, 1024, F.G, bx);
                EpiPre E{(bf16*)(ws + WS_PRE), HBc, isa ? inp(IN_BOUT) + layer * 1024 : nullptr};
                pg8::gemm_phase<EpiPre, pg8::StaticOrder, true, true>(F.lds, g, S, E, F.tid);
                FRESH(); sgemm64(F, g.A, g.Bt, TP, TS / 64, 16, g.K, E);
            } else if (sub == 3 && PHM(7)) {
                FRESH();
                phase_ln1(F, layer, HBc);
            } else if (sub == 4 && PHM(8)) {
                FRESH();
                pg8::Gemm g{(const bf16*)(ws + WS_WQK) + (size_t)layer * 2048 * 1024, HBc, 2048, T, 1024};
                pg8::StaticOrder S; S.init(2048, T, F.G, bx);
                EpiF32 E{(unsigned*)(ws + WS_SC), T};
                pg8::gemm_phase<EpiF32, pg8::StaticOrder, true, true>(F.lds, g, S, E, F.tid);
                FRESH(); table_filler(F, layer, 1, 8 * (T / 256));
                if (layer == 3) table_filler(F, layer, 0, 8 * (T / 256));
            } else if (sub == 5 && PHM(9)) {
                FRESH();
                phase_topk(F);
            } else if (sub == 6 && PHM(10)) {
                FRESH();
                phase_gather(F, layer, HBc, ((DBG_REP >> 6) & 1) ? dry : false);
            } else if (sub == 7 && PHM(11)) {
                FRESH();
                pg8::Gemm g{HBc, (const bf16*)(ws + WS_GATE) + (size_t)layer * 1024 * 1024, TP, 1024, 1024};
                pg8::StaticOrder S; S.init(TP, 1024, F.G, bx);
                EpiGate E{HBc, HBn, (const bf16*)(ws + WS_PP) + (size_t)layer * T * 1024, inp(IN_GB) + layer * 1024, layer == 3 ? F.out : nullptr};
                pg8::gemm_phase<EpiGate, pg8::StaticOrder, true, true>(F.lds, g, S, E, F.tid);
                FRESH(); sgemm64(F, g.A, g.Bt, TP, TS / 64, 16, g.K, E);
            }
        }
        const bool same_wg_seam = (MK_N_LAUNCHES == 1) && (ph >= 2) && (((ph - 2) & 7) == 5);
        if (ph == 1 && MK_N_LAUNCHES == 1) { }
        else if (same_wg_seam) { asm volatile("s_waitcnt vmcnt(0)" ::: "memory"); __syncthreads(); }
        else if (it + 1 < 2 * args.ph_hi) { int l_; asm volatile("v_mbcnt_lo_u32_b32 %0, -1, 0\n\tv_mbcnt_hi_u32_b32 %0, -1, %0" : "=v"(l_)); xcd_barrier(bar, wave0 * 64 + l_); if ((DBG_REP >> 11) & 1) xcd_barrier(bar, wave0 * 64 + l_); }
    }
}

extern "C" void kernel_launch(void* const* d_in, const int* in_sizes, int n_in, void* d_out, int out_size, void* d_ws, size_t ws_size, hipStream_t stream) {
    static int grid = 0;
    if (grid == 0) {
        if (n_in != 29 || (size_t)out_size != O_END || ws_size < WS_END) {
            fprintf(stderr, "kernel_launch: built for 29 inputs, %zu outputs, >= %zu bytes of workspace; got n_in %d, out %d, ws %zu; nothing launched\n", (size_t)O_END, (size_t)WS_END, n_in, out_size, ws_size);
            grid = -1; return;
        }
        int dev = 0, cus = 0;
        if (hipGetDevice(&dev) != hipSuccess || hipDeviceGetAttribute(&cus, hipDeviceAttributeMultiprocessorCount, dev) != hipSuccess) { grid = -1; return; }
        if (hipFuncSetAttribute((const void*)yoco_fwd, hipFuncAttributeMaxDynamicSharedMemorySize, LDS_BYTES) != hipSuccess) { fprintf(stderr, "kernel_launch: hipFuncSetAttribute failed\n"); grid = -1; return; }
        (void)hipGetLastError();
        grid = cus;
    }
    if (grid < 0) return;
    if (hipMemsetAsync((char*)d_ws + WS_CTL, 0, CTL_ZERO_BYTES, stream) != hipSuccess) { fprintf(stderr, "kernel_launch: hipMemsetAsync failed\n"); return; }
    Args a{};
    for (int i = 0; i < 29; ++i) a.in[i] = (const float*)d_in[i];
    a.out = (float*)d_out; a.ws = (unsigned char*)d_ws;
#if MK_N_LAUNCHES == 1
    a.ph_lo = 0; a.ph_hi = NPHASE;
    hipLaunchKernelGGL(yoco_fwd, dim3(grid), dim3(NWAVES * 64), LDS_BYTES, stream, a);
#else
    for (int ph = 0; ph < NPHASE; ++ph) { a.ph_lo = ph; a.ph_hi = ph + 1; hipLaunchKernelGGL(yoco_fwd, dim3(grid), dim3(NWAVES * 64), LDS_BYTES, stream, a); }
#endif
    const hipError_t le = hipPeekAtLastError();
    if (le != hipSuccess) fprintf(stderr, "kernel_launch: launch failed: %s (grid %d)\n", hipGetErrorName(le), grid);
}
```

```cpp
#include <hip/hip_runtime.h>
#include <cstdio>
#include <cstdint>
namespace pg8 {
#define PG8_LAS __attribute__((address_space(3)))
typedef unsigned short bf16_t;
typedef short bf16x8 __attribute__((ext_vector_type(8)));
typedef float f32x4 __attribute__((ext_vector_type(4)));
typedef unsigned u32x4 __attribute__((ext_vector_type(4)));
constexpr int BM = 256, BK = 64, HALF = 128, HTB = HALF * BK * 2  , STAGE_BYTES = 8 * HTB, NXCD = 8, WGM = 8;

__host__ __device__ __forceinline__ int lds_byte(int r, int c) { const int st = (r >> 4) * 2 + (c >> 5), rr = r & 15, cc = c & 31, ob = rr * 64 + cc * 2; return st * 1024 + (ob ^ (((ob >> 9) & 1) << 5)); }
__host__ __device__ __forceinline__ void stage_rc(int b, int& R, int& C) { const int st = b / 1024, sb = b % 1024, swz = sb ^ (((sb >> 9) & 1) << 5); R = (st >> 1) * 16 + swz / 64; C = (st & 1) * 32 + (swz % 64) / 2; }
__host__ __device__ __forceinline__ int perm32(int rho) { const int n = rho >> 4, i = rho & 15; return 8 * (i >> 2) + 4 * n + (i & 3); }

struct Unit { int pm, pn, pb; };
struct Gemm { const bf16_t* A; const bf16_t* Bt; int M, N, K; };

struct StaticOrder {
    int nM, nN, nwg, G, c, mper;
    __host__ __device__ void init(int M, int N, int G_, int c_, int mper_ = 1 << 28) { nM = M / BM; nN = N / BM; nwg = nM * nN; G = G_; c = c_; mper = mper_; }
    __host__ __device__ bool next(int i, Unit& u) const {
        const long L = (long)i * G + c; if (L >= nwg) return false;
        int wgid = (int)L; { const int q = nwg / NXCD, r = nwg % NXCD, xcd = wgid % NXCD, off = wgid / NXCD; wgid = (xcd < r ? xcd * (q + 1) : r * (q + 1) + (xcd - r) * q) + off; }
        const int nig = WGM * nN, gid = wgid / nig, fm = gid * WGM, gsz = (nM - fm) < WGM ? (nM - fm) : WGM;
        u.pm = fm + ((wgid % nig) % gsz); u.pn = (wgid % nig) / gsz; u.pb = ((u.pm >= mper) + (u.pm >= 2 * mper) + (u.pm >= 3 * mper)) * nN + u.pn; return true;
    }
    __device__ __forceinline__ void a_ready(const Unit&) const {}
    __device__ __forceinline__ void done(const Unit&) const {}
};
__device__ __forceinline__ unsigned cvt_pk_bf16(float lo, float hi) { unsigned r; asm volatile("v_cvt_pk_bf16_f32 %0, %1, %2" : "=v"(r) : "v"(lo), "v"(hi)); return r; }
typedef float f32x2 __attribute__((ext_vector_type(2)));
template <class Epi, class Sched, bool ALIGN_EPI = false, bool SP2 = false>
__device__ __forceinline__ void gemm_phase(PG8_LAS unsigned char* lds, const Gemm g, const Sched& S, const Epi& E, int tid_in) {
    int tid_ = tid_in; asm volatile("" : "+v"(tid_));
    const int tid = tid_, wid = __builtin_amdgcn_readfirstlane(tid >> 6), lane = tid & 63, wr = wid >> 2, wc = wid & 3, fr = lane & 15, fq = lane >> 4;
    const int K = g.K, nt = K / BK;
    unsigned voffA[2], voffB[2];
#pragma unroll
    for (int i = 0; i < 2; ++i) { int R, C; stage_rc(tid * 16 + i * 8192, R, C); const int Rb = Epi::PERM ? ((R & ~31) + perm32(R & 31)) : R;
        voffA[i] = (unsigned)(R * K + C) * 2u; voffB[i] = (unsigned)(Rb * K + C) * 2u; }
    const size_t kstep = (size_t)(BK * 2);
    const size_t hstep = (size_t)HALF * K * 2;
    const size_t tstep = 2 * hstep;
    const unsigned ldsw = (unsigned)wid * 1024u;
    const int aoff = lds_byte(wr * 64 + fr, fq * 8), boff = lds_byte(wc * 32 + fr, fq * 8);
#define PG8_SA(b, h) (((b) * 2 + (h)) * HTB)
#define PG8_SB(b, h) ((4 + (b) * 2 + (h)) * HTB)
#define PG8_STAGE(bufoff, gbase, voff) do { _Pragma("unroll") for (int _i = 0; _i < 2; ++_i) \
        __builtin_amdgcn_global_load_lds((const unsigned*)((const char*)(gbase) + (voff)[_i]), (PG8_LAS unsigned*)(lds + (bufoff) + ldsw + _i * 8192), 16, 0, 0); } while (0)
#define PG8_LDA(dst, b, h) do { _Pragma("unroll") for (int m = 0; m < 4; ++m) _Pragma("unroll") for (int k = 0; k < 2; ++k) dst[m][k] = *(const PG8_LAS bf16x8*)(lds + PG8_SA(b, h) + aoff + m * 2048 + k * 1024); } while (0)
#define PG8_LDB(dst, b, h) do { _Pragma("unroll") for (int n = 0; n < 2; ++n) _Pragma("unroll") for (int k = 0; k < 2; ++k) dst[n][k] = *(const PG8_LAS bf16x8*)(lds + PG8_SB(b, h) + boff + n * 2048 + k * 1024); } while (0)
#define PG8_MMA(ai, bj, At, Bt) do { __builtin_amdgcn_s_setprio(1); _Pragma("unroll") for (int m = 0; m < 4; ++m) _Pragma("unroll") for (int n = 0; n < 2; ++n) _Pragma("unroll") for (int k = 0; k < 2; ++k) \
        acc[ai][bj][m][n] = __builtin_amdgcn_mfma_f32_16x16x32_bf16(Bt[n][k], At[m][k], acc[ai][bj][m][n], 0, 0, 0); __builtin_amdgcn_s_setprio(0); } while (0)
#define PG8_WAIT_V(n) asm volatile("s_waitcnt vmcnt(" #n ")" ::: "memory")
#define PG8_WAIT_L(n) asm volatile("s_waitcnt lgkmcnt(" #n ")" ::: "memory")
#define PG8_BAR __builtin_amdgcn_s_barrier()
#define PG8_SCHED __builtin_amdgcn_sched_barrier(0)
    Unit cur, nxt; int ui = 0;
    if (!S.next(0, cur)) return;
    f32x4 acc[2][2][4][2];
#pragma unroll
    for (int a = 0; a < 2; ++a)
#pragma unroll
        for (int b = 0; b < 2; ++b)
#pragma unroll
            for (int m = 0; m < 4; ++m)
#pragma unroll
                for (int n = 0; n < 2; ++n) acc[a][b][m][n] = (f32x4){0.f, 0.f, 0.f, 0.f};
    bf16x8 At[4][2], B0[2][2], B1[2][2];
    const char* cA = (const char*)g.A + (size_t)cur.pm * tstep; const char* cB = (const char*)g.Bt + (size_t)cur.pb * tstep;
    S.a_ready(cur);
    if constexpr (SP2) {
        PG8_STAGE(PG8_SB(0, 0), cB, voffB); PG8_STAGE(PG8_SB(0, 1), cB + hstep, voffB); PG8_STAGE(PG8_SA(0, 0), cA, voffA); PG8_STAGE(PG8_SA(0, 1), cA + hstep, voffA);
        if (wr == 1) PG8_BAR;
        PG8_WAIT_V(2); PG8_BAR;
        PG8_STAGE(PG8_SB(1, 0), cB + kstep, voffB); PG8_STAGE(PG8_SA(1, 0), cA + kstep, voffA); PG8_STAGE(PG8_SB(1, 1), cB + hstep + kstep, voffB);
        PG8_WAIT_V(6); PG8_BAR;
    } else {
        PG8_STAGE(PG8_SB(0, 0), cB, voffB); PG8_STAGE(PG8_SA(0, 0), cA, voffA); PG8_STAGE(PG8_SB(0, 1), cB + hstep, voffB); PG8_STAGE(PG8_SA(0, 1), cA + hstep, voffA);
        if (wr == 1) PG8_BAR;
        PG8_WAIT_V(4); PG8_BAR;
        PG8_STAGE(PG8_SB(1, 0), cB + kstep, voffB); PG8_STAGE(PG8_SA(1, 0), cA + kstep, voffA); PG8_STAGE(PG8_SB(1, 1), cB + hstep + kstep, voffB);
        PG8_WAIT_V(6); PG8_BAR;
    }
    for (;;) {
        const bool has_next = S.next(ui + 1, nxt);
        const char* nA = has_next ? (const char*)g.A + (size_t)nxt.pm * tstep : cA; const char* nB = has_next ? (const char*)g.Bt + (size_t)nxt.pb * tstep : cB;
        for (int t = 0; t < nt; t += 2) {
            const bool last = (t == nt - 2);
            const char* a1 = cA + (size_t)(t + 1) * kstep;
            const char* a2 = last ? nA : cA + (size_t)(t + 2) * kstep; const char* b2 = last ? nB : cB + (size_t)(t + 2) * kstep;
            const char* a3 = a2 + kstep; const char* b3 = b2 + kstep;
            if (last && has_next) S.a_ready(nxt);
            if constexpr (SP2) {
            PG8_LDB(B0, 0, 0); PG8_LDB(B1, 0, 1); PG8_SCHED; PG8_LDA(At, 0, 0); PG8_STAGE(PG8_SA(1, 1), a1 + hstep, voffA);
            PG8_WAIT_V(8); PG8_WAIT_L(0); PG8_BAR; PG8_MMA(0, 0, At, B0); PG8_MMA(0, 1, At, B1); PG8_BAR; PG8_SCHED;
            PG8_LDA(At, 0, 1); PG8_STAGE(PG8_SB(0, 0), b2, voffB); PG8_STAGE(PG8_SB(0, 1), b2 + hstep, voffB); PG8_STAGE(PG8_SA(0, 0), a2, voffA);
            PG8_WAIT_V(8); PG8_WAIT_L(0); PG8_BAR; PG8_MMA(1, 0, At, B0); PG8_MMA(1, 1, At, B1); PG8_BAR; PG8_SCHED;
            PG8_LDB(B0, 1, 0); PG8_LDB(B1, 1, 1); PG8_SCHED; PG8_LDA(At, 1, 0); PG8_STAGE(PG8_SA(0, 1), a2 + hstep, voffA);
            PG8_WAIT_V(8); PG8_WAIT_L(0); PG8_BAR; PG8_MMA(0, 0, At, B0); PG8_MMA(0, 1, At, B1); PG8_BAR; PG8_SCHED;
            PG8_LDA(At, 1, 1); PG8_STAGE(PG8_SB(1, 0), b3, voffB); PG8_STAGE(PG8_SB(1, 1), b3 + hstep, voffB); PG8_STAGE(PG8_SA(1, 0), a3, voffA);
            PG8_WAIT_V(8); PG8_WAIT_L(0); PG8_BAR; PG8_MMA(1, 0, At, B0); PG8_MMA(1, 1, At, B1); PG8_BAR; PG8_SCHED;
            } else {
            PG8_LDB(B0, 0, 0); PG8_SCHED; PG8_LDA(At, 0, 0); PG8_STAGE(PG8_SA(1, 1), a1 + hstep, voffA);
            PG8_WAIT_L(8); PG8_BAR; PG8_WAIT_L(0); PG8_MMA(0, 0, At, B0); PG8_BAR; PG8_SCHED;
            PG8_LDB(B1, 0, 1); PG8_STAGE(PG8_SB(0, 0), b2, voffB);
            PG8_BAR; PG8_WAIT_L(0); PG8_MMA(0, 1, At, B1); PG8_BAR;
            PG8_LDA(At, 0, 1); PG8_STAGE(PG8_SA(0, 0), a2, voffA);
            PG8_BAR; PG8_WAIT_L(0); PG8_MMA(1, 0, At, B0); PG8_BAR; PG8_SCHED;
            PG8_STAGE(PG8_SB(0, 1), b2 + hstep, voffB);
            PG8_WAIT_V(6); PG8_BAR; PG8_MMA(1, 1, At, B1); PG8_BAR;
            PG8_LDB(B0, 1, 0); PG8_SCHED; PG8_LDA(At, 1, 0); PG8_STAGE(PG8_SA(0, 1), a2 + hstep, voffA);
            PG8_WAIT_L(8); PG8_BAR; PG8_WAIT_L(0); PG8_MMA(0, 0, At, B0); PG8_BAR; PG8_SCHED;
            PG8_LDB(B1, 1, 1); PG8_STAGE(PG8_SB(1, 0), b3, voffB);
            PG8_BAR; PG8_WAIT_L(0); PG8_MMA(0, 1, At, B1); PG8_BAR;
            PG8_LDA(At, 1, 1); PG8_STAGE(PG8_SA(1, 0), a3, voffA);
            PG8_BAR; PG8_WAIT_L(0); PG8_MMA(1, 0, At, B0); PG8_BAR; PG8_SCHED;
            PG8_STAGE(PG8_SB(1, 1), b3 + hstep, voffB);
            PG8_WAIT_V(6); PG8_BAR; PG8_MMA(1, 1, At, B1); PG8_BAR;
            }
        }
        if constexpr (ALIGN_EPI) { if (wr == 0) PG8_BAR; }
        if constexpr (!Epi::AFTER_DRAIN) { E(acc, cur, wr, wc, fr, fq); S.done(cur); }
        if (!has_next) break;
#pragma unroll
        for (int a = 0; a < 2; ++a)
#pragma unroll
            for (int b = 0; b < 2; ++b)
#pragma unroll
                for (int m = 0; m < 4; ++m)
#pragma unroll
                    for (int n = 0; n < 2; ++n) acc[a][b][m][n] = (f32x4){0.f, 0.f, 0.f, 0.f};
        cur = nxt; cA = nA; cB = nB; ++ui;
        if constexpr (ALIGN_EPI) { if (wr == 1) PG8_BAR; }
    }
    PG8_WAIT_V(0);
    if constexpr (!ALIGN_EPI) { if (wr == 0) PG8_BAR; }
    PG8_BAR;
    if constexpr (Epi::AFTER_DRAIN) { E.fused(acc, cur, wr, wc, fr, fq, lds, wid, lane); S.done(cur); }
#undef PG8_SA
#undef PG8_SB
#undef PG8_STAGE
#undef PG8_LDA
#undef PG8_LDB
#undef PG8_MMA
#undef PG8_WAIT_V
#undef PG8_WAIT_L
#undef PG8_BAR
#undef PG8_SCHED
}
}

#ifndef MK_N_LAUNCHES
#define MK_N_LAUNCHES 1
#endif
constexpr int NWAVES = 8;
constexpr int TP = 16384, TS = 1024, T = TP + TS;
constexpr int D = 1024, DSGU = 2048, NEXP = 16384, DPLE = 256;
constexpr int NPHASE = 34;
constexpr float ALPHA = 1.681792830507429f;
constexpr float LN_EPS = 1e-5f;
constexpr size_t O_YP = 0, O_YS = 16777216, O_KP = 17825792, O_VP = 17858560, O_KS = 17891328, O_VS = 19988480, O_SGU = 22085632, O_END = 26279936;

constexpr size_t MiB = 1u << 20;
constexpr size_t WS_CTL = 0, CTL_ZERO_BYTES = 65536;
constexpr size_t WS_STATS = 925 * MiB;
constexpr size_t WS_WIN = 2 * MiB;
constexpr size_t WS_WOUT = 18 * MiB;
constexpr size_t WS_WQKV = 26 * MiB;
constexpr size_t WS_WQ1 = 29 * MiB;
constexpr size_t WS_WO = 31 * MiB;
constexpr size_t WS_WQK = 35 * MiB;
constexpr size_t WS_PLE = 51 * MiB;
constexpr size_t WS_GATE = 53 * MiB;
constexpr size_t WS_WSB = 61 * MiB;
constexpr size_t WS_PU = 64 * MiB;
constexpr size_t WS_PV = 128 * MiB;
constexpr size_t WS_PBF = 320 * MiB;
constexpr size_t WS_PP = 354 * MiB;
constexpr size_t WS_HF = 490 * MiB;
constexpr size_t WS_HB = 558 * MiB;
constexpr size_t WS_PRE = 592 * MiB;
constexpr size_t WS_Z = 660 * MiB;
constexpr size_t WS_SC = 660 * MiB;
constexpr size_t WS_GATED = 796 * MiB;
constexpr size_t WS_QB = 796 * MiB;
constexpr size_t WS_ATT = 830 * MiB;
constexpr size_t WS_EIDX = 864 * MiB;
constexpr size_t WS_GW = 873 * MiB;
constexpr size_t WS_KVB = 882 * MiB;
constexpr size_t WS_HB2 = 891 * MiB;
constexpr size_t WS_END = 930 * MiB;
constexpr int CW_BAR = 4096;

constexpr int RING_BYTES = 131072;
constexpr int LDSCTL_OFF = RING_BYTES, MISC_OFF = LDSCTL_OFF + 320;
constexpr int LDS_BYTES = 147456;

#define GAS __attribute__((address_space(1)))
#define LAS __attribute__((address_space(3)))
typedef unsigned short bf16;
typedef unsigned v4u __attribute__((ext_vector_type(4)));
typedef unsigned v2u __attribute__((ext_vector_type(2)));
typedef float f32x4 __attribute__((ext_vector_type(4)));
typedef float f32x2 __attribute__((ext_vector_type(2)));
typedef float f32x16 __attribute__((ext_vector_type(16)));
typedef short bf16x8 __attribute__((ext_vector_type(8)));
typedef short s16x4 __attribute__((ext_vector_type(4)));
typedef __bf16 bf16x2v __attribute__((ext_vector_type(2)));
typedef GAS unsigned gu32;
#define RLX_AGENT __ATOMIC_RELAXED, __HIP_MEMORY_SCOPE_AGENT
#define LDS_WAIT() asm volatile("s_waitcnt lgkmcnt(0)" ::: "memory")
#define VM_WAIT() asm volatile("s_waitcnt vmcnt(0)" ::: "memory")
__device__ __forceinline__ unsigned f2bf(float f) { unsigned u = __builtin_bit_cast(unsigned, f); return (u + 0x7fffu + ((u >> 16) & 1u)) >> 16; }
typedef __bf16 bf2v __attribute__((ext_vector_type(2)));
__device__ __forceinline__ unsigned pk2(float lo, float hi) { const bf2v v = {(__bf16)lo, (__bf16)hi}; return __builtin_bit_cast(unsigned, v); }
__device__ __forceinline__ float bflo(unsigned w) { return __builtin_bit_cast(float, w << 16); }
__device__ __forceinline__ float bfhi(unsigned w) { return __builtin_bit_cast(float, w & 0xffff0000u); }
__device__ __forceinline__ float bf2f(bf16 b) { return __builtin_bit_cast(float, ((unsigned)b) << 16); }
__device__ __forceinline__ float dot2_bf16(unsigned w, unsigned x, float acc) { return __builtin_amdgcn_fdot2_f32_bf16(__builtin_bit_cast(bf16x2v, w), __builtin_bit_cast(bf16x2v, x), acc, false); }
__device__ __forceinline__ float fexp2(float x) { return __builtin_amdgcn_exp2f(x); }
__device__ __forceinline__ float frcp(float x) { return __builtin_amdgcn_rcpf(x); }
__device__ __forceinline__ float gelu_tanh(float x) {
    const float t = x * (0.7978845608028654f + 0.035677408136300125f * x * x);
    return x * frcp(1.0f + fexp2(-2.8853900817779268f * t));
}
__device__ __forceinline__ float sigmoidf_(float x) { return frcp(1.0f + fexp2(-1.4426950408889634f * x)); }
__device__ __forceinline__ float row16_sum(float v) {
    v += __builtin_bit_cast(float, __builtin_amdgcn_update_dpp(0, __builtin_bit_cast(int, v), 0xB1, 0xF, 0xF, true));
    v += __builtin_bit_cast(float, __builtin_amdgcn_update_dpp(0, __builtin_bit_cast(int, v), 0x4E, 0xF, 0xF, true));
    v += __builtin_bit_cast(float, __builtin_amdgcn_update_dpp(0, __builtin_bit_cast(int, v), 0x141, 0xF, 0xF, true));
    v += __builtin_bit_cast(float, __builtin_amdgcn_update_dpp(0, __builtin_bit_cast(int, v), 0x140, 0xF, 0xF, true));
    return v;
}

__device__ __forceinline__ float bperm(int src_lane, float v) { return __builtin_bit_cast(float, __builtin_amdgcn_ds_bpermute(src_lane << 2, __builtin_bit_cast(int, v))); }
__device__ __forceinline__ float wave_sum(float v) {
    v = row16_sum(v);
    v += __builtin_bit_cast(float, __builtin_amdgcn_update_dpp(0, __builtin_bit_cast(int, v), 0x142, 0xA, 0xF, false));
    v += __builtin_bit_cast(float, __builtin_amdgcn_update_dpp(0, __builtin_bit_cast(int, v), 0x143, 0xC, 0xF, false));
    return __builtin_bit_cast(float, __builtin_amdgcn_readlane(__builtin_bit_cast(int, v), 63));
}
__device__ __forceinline__ float wave_max(float v) {
    const int ninf = (int)0xff800000u;
    v = fmaxf(v, __builtin_bit_cast(float, __builtin_amdgcn_update_dpp(ninf, __builtin_bit_cast(int, v), 0xB1, 0xF, 0xF, false)));
    v = fmaxf(v, __builtin_bit_cast(float, __builtin_amdgcn_update_dpp(ninf, __builtin_bit_cast(int, v), 0x4E, 0xF, 0xF, false)));
    v = fmaxf(v, __builtin_bit_cast(float, __builtin_amdgcn_update_dpp(ninf, __builtin_bit_cast(int, v), 0x141, 0xF, 0xF, false)));
    v = fmaxf(v, __builtin_bit_cast(float, __builtin_amdgcn_update_dpp(ninf, __builtin_bit_cast(int, v), 0x140, 0xF, 0xF, false)));
    v = fmaxf(v, __builtin_bit_cast(float, __builtin_amdgcn_update_dpp(ninf, __builtin_bit_cast(int, v), 0x142, 0xA, 0xF, false)));
    v = fmaxf(v, __builtin_bit_cast(float, __builtin_amdgcn_update_dpp(ninf, __builtin_bit_cast(int, v), 0x143, 0xC, 0xF, false)));
    return __builtin_bit_cast(float, __builtin_amdgcn_readlane(__builtin_bit_cast(int, v), 63));
}
#define XB_TMO      128
#define XB_XCNT(j)  (256  + 64 * (j))
#define XB_XSUB(j)  (1280 + 64 * (j))
#define XB_XGEN(j)  (2304 + 64 * (j))
#define XB_TOP      3328
#define XB_TOPGEN   3392
#define XCD_BAR_WORDS 3456
#define XB_SPIN_CAP (1u << 18)

__device__ __forceinline__ unsigned xb_ld(unsigned* p)              { return __hip_atomic_load(p, __ATOMIC_RELAXED, __HIP_MEMORY_SCOPE_AGENT); }
__device__ __forceinline__ unsigned xb_add(unsigned* p, unsigned v) { return __hip_atomic_fetch_add(p, v, __ATOMIC_RELAXED, __HIP_MEMORY_SCOPE_AGENT); }
__device__ __forceinline__ unsigned xb_xcc_id() { return (unsigned)__builtin_amdgcn_s_getreg((3 << 11) | 20) & 0xFu; }
#define XB_SPIN(cond, bar) do { unsigned _sp = 0; while (cond) { __builtin_amdgcn_s_sleep(1); \
    if ((++_sp & 255u) == 0u) { if (xb_ld(&(bar)[XB_TMO])) break; if (_sp > XB_SPIN_CAP) { atomicAdd(&(bar)[XB_TMO], 1u); break; } } } } while (0)

struct XcdBarrier {
    unsigned* bar; unsigned x;
    volatile LAS unsigned* st;
};

__device__ __forceinline__ XcdBarrier xcd_barrier_post(unsigned* bar, volatile LAS unsigned* st) {
    XcdBarrier b; b.bar = bar; b.x = xb_xcc_id(); b.st = st;
    if (threadIdx.x == 0) (void)xb_add(&bar[XB_XCNT(b.x)], 1u);
    return b;
}
__device__ __forceinline__ void xcd_barrier_complete(unsigned* bar, unsigned x, unsigned& nloc, unsigned& nx) {
    const unsigned G = gridDim.x * gridDim.y * gridDim.z;
    unsigned sum, cnt, mine, sp = 0u;
    for (;;) {
        sum = 0u; cnt = 0u; mine = 0u;
#pragma unroll
        for (unsigned j = 0; j < 16; ++j) { const unsigned c = xb_ld(&bar[XB_XCNT(j)]); sum += c; cnt += (c > 0u) ? 1u : 0u; mine = (j == x) ? c : mine; }
        if (sum == G) break;
        __builtin_amdgcn_s_sleep(1);
        if ((++sp & 255u) == 0u) { if (xb_ld(&bar[XB_TMO])) break; if (sp > XB_SPIN_CAP) { atomicAdd(&bar[XB_TMO], 1u); break; } }
    }
    nloc = mine > 0u ? mine : 1u; nx = cnt > 0u ? cnt : 1u;
}

__device__ __forceinline__ void xcd_barrier(const XcdBarrier& b, int tid) {
    asm volatile("s_waitcnt vmcnt(0)" ::: "memory");
    __syncthreads();
    if (tid == 0) {
        unsigned* bar = b.bar;
        __builtin_amdgcn_s_waitcnt(0);
        unsigned nloc = b.st[0], nx = b.st[1];
        if (nloc == 0u) { xcd_barrier_complete(bar, b.x, nloc, nx); b.st[0] = nloc; b.st[1] = nx; }
        const unsigned old = xb_add(&bar[XB_XSUB(b.x)], 1u);
        const unsigned gen = old / nloc;
        if (old + 1u == (gen + 1u) * nloc) {
            __builtin_amdgcn_fence(__ATOMIC_RELEASE, "agent");
            asm volatile("s_waitcnt vmcnt(0)" ::: "memory");
            const unsigned og = xb_add(&bar[XB_TOP], 1u);
            const unsigned tg = og / nx;
            if (og + 1u == (tg + 1u) * nx) xb_add(&bar[XB_TOPGEN], 1u);
            else XB_SPIN(xb_ld(&bar[XB_TOPGEN]) == tg, bar);
            __builtin_amdgcn_fence(__ATOMIC_ACQUIRE, "agent");
            xb_add(&bar[XB_XGEN(b.x)], 1u);
            asm volatile("s_waitcnt vmcnt(0)" ::: "memory");
        } else {
            XB_SPIN(xb_ld(&bar[XB_XGEN(b.x)]) == gen, bar);
            __builtin_amdgcn_fence(__ATOMIC_ACQUIRE, "agent");
            asm volatile("s_waitcnt vmcnt(0)" ::: "memory");
        }
    }
    __syncthreads();
}

struct Frame {
    LAS unsigned char* lds;
    volatile LAS unsigned* MISC;
    gu32* ctl;
    int tid, lane, wave, G, bx;
    float* out;
    unsigned char* ws;
};
#define IN_XP 0
#define IN_XS 1
#define IN_CK 2
#define IN_CV 3
#define IN_PPR 4
#define IN_PSA 5
#define IN_LN1G 6
#define IN_LN1B 7
#define IN_LN2G 8
#define IN_LN2B 9
#define IN_WIN 10
#define IN_BIN 11
#define IN_SLNG 12
#define IN_SLNB 13
#define IN_WS 14
#define IN_BS 15
#define IN_WOUT 16
#define IN_BOUT 17
#define IN_WKV 18
#define IN_WQ 19
#define IN_SINK 20
#define IN_WO 21
#define IN_PWQ 22
#define IN_SUBK 23
#define IN_PU 24
#define IN_PV 25
#define IN_PLEW 26
#define IN_GW 27
#define IN_GB 28

typedef const GAS float* CFPtr;
__device__ __forceinline__ const float* inp(int k) {
    const __attribute__((address_space(4))) CFPtr* ka = (const __attribute__((address_space(4))) CFPtr*)__builtin_amdgcn_kernarg_segment_ptr();
    asm volatile("" : "+s"(ka));
    return (const float*)ka[k];
}

using pg8::Unit;
typedef const f32x4 (&AccRef)[2][2][4][2];

struct EpiZ {
    static constexpr bool PERM = true, AFTER_DRAIN = false;
    bf16* Z; const float* bias; float* stats;
    __device__ __forceinline__ void operator()(AccRef acc, const Unit& u, int wr, int wc, int fr, int fq) const {
        asm volatile("" : "+v"(fr), "+v"(fq));
        const int row0 = u.pm * 256 + wr * 64 + fr, col0 = u.pn * 256 + wc * 32 + 8 * fq;
        const bool isv = u.pn >= 8;
        f32x4 bv[2][2];
#pragma unroll
        for (int bj = 0; bj < 2; ++bj)
#pragma unroll
            for (int n = 0; n < 2; ++n) bv[bj][n] = *(const f32x4*)(bias + col0 + bj * 128 + 4 * n);
#pragma unroll
        for (int ai = 0; ai < 2; ++ai)
#pragma unroll
            for (int m = 0; m < 4; ++m) {
                const int row = row0 + ai * 128 + m * 16;
                float s1 = 0.f, s2 = 0.f;
#pragma unroll
                for (int bj = 0; bj < 2; ++bj) {
                    f32x4 v0 = acc[ai][bj][m][0] + bv[bj][0], v1 = acc[ai][bj][m][1] + bv[bj][1];
#pragma unroll
                    for (int e = 0; e < 4; ++e) { v0[e] = gelu_tanh(v0[e]); v1[e] = gelu_tanh(v1[e]); }
                    v4u w; w.x = pk2(v0[0], v0[1]); w.y = pk2(v0[2], v0[3]); w.z = pk2(v1[0], v1[1]); w.w = pk2(v1[2], v1[3]);
                    *(v4u*)(Z + (size_t)row * 4096 + col0 + bj * 128) = w;
                    const float r0 = bflo(w.x), r1 = bfhi(w.x), r2 = bflo(w.y), r3 = bfhi(w.y), r4 = bflo(w.z), r5 = bfhi(w.z), r6 = bflo(w.w), r7 = bfhi(w.w);
                    s1 += ((r0 + r1) + (r2 + r3)) + ((r4 + r5) + (r6 + r7));
                    s2 += ((r0 * r0 + r1 * r1) + (r2 * r2 + r3 * r3)) + ((r4 * r4 + r5 * r5) + (r6 * r6 + r7 * r7));
                }
                if (isv) {
                    const int ln = fq * 16 + fr;
                    s1 += bperm(ln ^ 16, s1); s1 += bperm(ln ^ 32, s1);
                    s2 += bperm(ln ^ 16, s2); s2 += bperm(ln ^ 32, s2);
                    if (fq == 0) *(f32x2*)(stats + ((size_t)row * 32 + (u.pn - 8) * 4 + wc) * 2) = (f32x2){s1, s2};
                }
            }
    }
};

struct EpiPre {
    static constexpr bool PERM = false, AFTER_DRAIN = false;
    bf16* pre; const bf16* hin; const float* bias;
    __device__ __forceinline__ void apply4(int row, int col, f32x4 a) const {
        const size_t o = (size_t)row * D + col;
        const f32x4 bv = bias ? *(const f32x4*)(bias + col) : (f32x4){0.f, 0.f, 0.f, 0.f};
        const v2u hw = *(const v2u*)(hin + o); const f32x4 h = (f32x4){bflo(hw.x), bfhi(hw.x), bflo(hw.y), bfhi(hw.y)};
        { const f32x4 r = h * ALPHA + a + bv; v2u w; w.x = pk2(r[0], r[1]); w.y = pk2(r[2], r[3]); *(v2u*)(pre + o) = w; }
    }
    __device__ __forceinline__ void operator()(AccRef acc, const Unit& u, int wr, int wc, int fr, int fq) const {
        asm volatile("" : "+v"(fr), "+v"(fq));
        const int row0 = u.pm * 256 + wr * 64 + fr, col0 = u.pn * 256 + wc * 32 + 4 * fq;
        f32x4 bv[2][2];
#pragma unroll
        for (int bj = 0; bj < 2; ++bj)
#pragma unroll
            for (int n = 0; n < 2; ++n) bv[bj][n] = bias ? *(const f32x4*)(bias + col0 + bj * 128 + n * 16) : (f32x4){0.f, 0.f, 0.f, 0.f};
#pragma unroll
        for (int ai = 0; ai < 2; ++ai) {
            v2u hq[4][2][2];
#pragma unroll
            for (int m = 0; m < 4; ++m)
#pragma unroll
                for (int bj = 0; bj < 2; ++bj)
#pragma unroll
                    for (int n = 0; n < 2; ++n) hq[m][bj][n] = *(const v2u*)(hin + (size_t)(row0 + ai * 128 + m * 16) * D + col0 + bj * 128 + n * 16);
#pragma unroll
            for (int m = 0; m < 4; ++m) {
                const size_t ro = (size_t)(row0 + ai * 128 + m * 16) * D + col0;
#pragma unroll
                for (int bj = 0; bj < 2; ++bj)
#pragma unroll
                    for (int n = 0; n < 2; ++n) {
                        const v2u hw = hq[m][bj][n]; const f32x4 h = (f32x4){bflo(hw.x), bfhi(hw.x), bflo(hw.y), bfhi(hw.y)};
                        { const f32x4 r = h * ALPHA + acc[ai][bj][m][n] + bv[bj][n]; v2u w; w.x = pk2(r[0], r[1]); w.y = pk2(r[2], r[3]); *(v2u*)(pre + ro + bj * 128 + n * 16) = w; }
                    }
            }
        }
    }
};

struct EpiF32 {
    static constexpr bool PERM = false, AFTER_DRAIN = false;
    unsigned* C; int ldc;
    __device__ __forceinline__ void operator()(AccRef acc, const Unit& u, int wr, int wc, int fr, int fq) const {
        asm volatile("" : "+v"(fr), "+v"(fq));
        const int row0 = u.pm * 128 + wr * 64 + fr, col0 = u.pn * 256 + wc * 32 + 4 * fq;
#pragma unroll
        for (int m = 0; m < 4; ++m) {
            unsigned* rowp = C + (size_t)(row0 + m * 16) * ldc + col0;
#pragma unroll
            for (int bj = 0; bj < 2; ++bj)
#pragma unroll
                for (int n = 0; n < 2; ++n) {
                    const f32x4 a0 = acc[0][bj][m][n], a1 = acc[1][bj][m][n];
                    *(v4u*)(rowp + bj * 128 + n * 16) = (v4u){pk2(a0[0], a1[0]), pk2(a0[1], a1[1]), pk2(a0[2], a1[2]), pk2(a0[3], a1[3])};
                }
        }
    }
};

struct EpiBf {
    static constexpr bool PERM = true, AFTER_DRAIN = false;
    bf16* O; int ldc;
    __device__ __forceinline__ void apply4(int row, int col, f32x4 a) const { v2u w; w.x = pk2(a[0], a[1]); w.y = pk2(a[2], a[3]); *(v2u*)(O + (size_t)row * ldc + col) = w; }
    __device__ __forceinline__ void operator()(AccRef acc, const Unit& u, int wr, int wc, int fr, int fq) const {
        asm volatile("" : "+v"(fr), "+v"(fq));
        const int row0 = u.pm * 256 + wr * 64 + fr, col0 = u.pn * 256 + wc * 32 + 8 * fq;
#pragma unroll
        for (int ai = 0; ai < 2; ++ai)
#pragma unroll
            for (int m = 0; m < 4; ++m) {
                bf16* rowp = O + (size_t)(row0 + ai * 128 + m * 16) * ldc + col0;
#pragma unroll
                for (int bj = 0; bj < 2; ++bj) {
                    const f32x4 v0 = acc[ai][bj][m][0], v1 = acc[ai][bj][m][1];
                    v4u w; w.x = pk2(v0[0], v0[1]); w.y = pk2(v0[2], v0[3]); w.z = pk2(v1[0], v1[1]); w.w = pk2(v1[2], v1[3]);
                    *(v4u*)(rowp + bj * 128) = w;
                }
            }
    }
};

struct EpiGate {
    static constexpr bool PERM = false, AFTER_DRAIN = false;
    const bf16* hin; bf16* hb; const bf16* pp; const float* gb; float* yout;
    __device__ __forceinline__ void apply4(int row, int col, f32x4 acc4) const {
        const size_t o = (size_t)row * D + col;
        const v2u hw = *(const v2u*)(hin + o); const f32x4 h = (f32x4){bflo(hw.x), bfhi(hw.x), bflo(hw.y), bfhi(hw.y)}; const v2u pw = *(const v2u*)(pp + o); const f32x4 a = acc4 + *(const f32x4*)(gb + col);
        f32x4 r;
        r[0] = h[0] + sigmoidf_(a[0]) * bflo(pw.x); r[1] = h[1] + sigmoidf_(a[1]) * bfhi(pw.x);
        r[2] = h[2] + sigmoidf_(a[2]) * bflo(pw.y); r[3] = h[3] + sigmoidf_(a[3]) * bfhi(pw.y);
        if (yout) { *(f32x4*)(yout + o) = r; }
        else { v2u w; w.x = pk2(r[0], r[1]); w.y = pk2(r[2], r[3]); *(v2u*)(hb + o) = w; }
    }
    __device__ __forceinline__ void operator()(AccRef acc, const Unit& u, int wr, int wc, int fr, int fq) const {
        asm volatile("" : "+v"(fr), "+v"(fq));
        const int row0 = u.pm * 256 + wr * 64 + fr, col0 = u.pn * 256 + wc * 32 + 4 * fq;
        f32x4 bv[2][2];
#pragma unroll
        for (int bj = 0; bj < 2; ++bj)
#pragma unroll
            for (int n = 0; n < 2; ++n) bv[bj][n] = *(const f32x4*)(gb + col0 + bj * 128 + n * 16);
#pragma unroll
        for (int ai = 0; ai < 2; ++ai) {
            v2u hq[4][2][2], pq[4][2][2];
#pragma unroll
            for (int m = 0; m < 4; ++m)
#pragma unroll
                for (int bj = 0; bj < 2; ++bj)
#pragma unroll
                    for (int n = 0; n < 2; ++n) { const size_t o = (size_t)(row0 + ai * 128 + m * 16) * D + col0 + bj * 128 + n * 16; hq[m][bj][n] = *(const v2u*)(hin + o); pq[m][bj][n] = *(const v2u*)(pp + o); }
#pragma unroll
            for (int m = 0; m < 4; ++m) {
                const size_t ro = (size_t)(row0 + ai * 128 + m * 16) * D + col0;
#pragma unroll
                for (int bj = 0; bj < 2; ++bj)
#pragma unroll
                    for (int n = 0; n < 2; ++n) {
                        const size_t o = ro + bj * 128 + n * 16;
                        const v2u hw = hq[m][bj][n]; const f32x4 h = (f32x4){bflo(hw.x), bfhi(hw.x), bflo(hw.y), bfhi(hw.y)};
                        const v2u pw = pq[m][bj][n];
                        const f32x4 a = acc[ai][bj][m][n] + bv[bj][n];
                        f32x4 r;
                        r[0] = h[0] + sigmoidf_(a[0]) * bflo(pw.x); r[1] = h[1] + sigmoidf_(a[1]) * bfhi(pw.x);
                        r[2] = h[2] + sigmoidf_(a[2]) * bflo(pw.y); r[3] = h[3] + sigmoidf_(a[3]) * bfhi(pw.y);
                        if (yout) { *(f32x4*)(yout + o) = r; }
                        else { v2u w; w.x = pk2(r[0], r[1]); w.y = pk2(r[2], r[3]); *(v2u*)(hb + o) = w; }
                    }
            }
        }
    }
};

struct EpiQKV {
    static constexpr bool PERM = true, AFTER_DRAIN = false;
    bf16* qb; bf16* kvb; float* out;
    __device__ __forceinline__ void apply4(int row, int col, f32x4 a) const {
        v2u w; w.x = pk2(a[0], a[1]); w.y = pk2(a[2], a[3]); *(v2u*)(qb + (size_t)row * D + col) = w;
    }
    __device__ __forceinline__ void operator()(AccRef acc, const Unit& u, int wr, int wc, int fr, int fq) const {
        asm volatile("" : "+v"(fr), "+v"(fq));
        const int row0 = u.pm * 256 + wr * 64 + fr, cl = wc * 32 + 8 * fq;
        const bool iskv = u.pn >= 4;
#pragma unroll
        for (int ai = 0; ai < 2; ++ai)
#pragma unroll
            for (int m = 0; m < 4; ++m) {
                const int row = row0 + ai * 128 + m * 16;
#pragma unroll
                for (int bj = 0; bj < 2; ++bj) {
                    const f32x4 v0 = acc[ai][bj][m][0], v1 = acc[ai][bj][m][1];
                    v4u w; w.x = pk2(v0[0], v0[1]); w.y = pk2(v0[2], v0[3]); w.z = pk2(v1[0], v1[1]); w.w = pk2(v1[2], v1[3]);
                    const int c = cl + bj * 128;
                    if (!iskv) { *(v4u*)(qb + (size_t)row * D + u.pn * 256 + c) = w; }
                    else {
                        *(v4u*)(kvb + (size_t)row * 256 + c) = w;
                        long widx = -1;
                        size_t base = 0;
                        if (row < TP) { const int s = row & 8191; if (s >= 8064) { widx = (long)(row >> 13) * 128 + (s - 8064); base = (bj == 0) ? O_KP : O_VP; } }
                        else { const int r = row - TP; widx = (long)(r >> 3) * 128 + 120 + (r & 7); base = (bj == 0) ? O_KS : O_VS; }
                        if (widx >= 0) { float* o = out + base + (size_t)widx * 128 + cl; *(f32x4*)o = v0; *(f32x4*)(o + 4) = v1; }
                    }
                }
            }
    }
};

template <class Epi>
__device__ __forceinline__ void sgemm64(Frame& F, const bf16* A, const bf16* Bt, int row_base, int nrt, int nct, int K, const Epi& E) {
    constexpr int PS = 68;
    LAS float* part = (LAS float*)F.lds;
    const int lane = F.lane, fr = lane & 15, fq = lane >> 4, wk = F.wave & 3, wm = F.wave >> 2, kper = K / 4;
    for (int tile = F.bx; tile < nrt * nct; tile += F.G) {
        const int rt = tile / nct, ct = tile % nct, r0 = row_base + rt * 64, c0 = ct * 64;
        f32x4 acc[2][4];
#pragma unroll
        for (int mt = 0; mt < 2; ++mt)
#pragma unroll
            for (int nt = 0; nt < 4; ++nt) acc[mt][nt] = (f32x4){0.f, 0.f, 0.f, 0.f};
        const bf16* Ap = A + (size_t)(r0 + wm * 32 + fr) * K + wk * kper + fq * 8;
        const bf16* Bp = Bt + (size_t)(c0 + fr) * K + wk * kper + fq * 8;
#pragma unroll 4
        for (int ks = 0; ks < kper / 32; ++ks) {
            bf16x8 af[2], bfr[4];
#pragma unroll
            for (int mt = 0; mt < 2; ++mt) af[mt] = *(const bf16x8*)(Ap + (size_t)mt * 16 * K + ks * 32);
#pragma unroll
            for (int nt = 0; nt < 4; ++nt) bfr[nt] = *(const bf16x8*)(Bp + (size_t)nt * 16 * K + ks * 32);
#pragma unroll
            for (int mt = 0; mt < 2; ++mt)
#pragma unroll
                for (int nt = 0; nt < 4; ++nt) acc[mt][nt] = __builtin_amdgcn_mfma_f32_16x16x32_bf16(bfr[nt], af[mt], acc[mt][nt], 0, 0, 0);
        }
#pragma unroll
        for (int mt = 0; mt < 2; ++mt)
#pragma unroll
            for (int nt = 0; nt < 4; ++nt) *(LAS f32x4*)(part + (size_t)((wk * 64 + wm * 32 + mt * 16 + fr) * PS + nt * 16 + 4 * fq)) = acc[mt][nt];
        __syncthreads();
        {
            const int row = F.tid >> 3, cg = (F.tid & 7) * 8;
            f32x4 s0 = (f32x4){0.f, 0.f, 0.f, 0.f}, s1 = (f32x4){0.f, 0.f, 0.f, 0.f};
#pragma unroll
            for (int w = 0; w < 4; ++w) { s0 += *(const LAS f32x4*)(part + (size_t)((w * 64 + row) * PS + cg)); s1 += *(const LAS f32x4*)(part + (size_t)((w * 64 + row) * PS + cg + 4)); }
            E.apply4(r0 + row, c0 + cg, s0); E.apply4(r0 + row, c0 + cg + 4, s1);
        }
        __syncthreads();
    }
}

__device__ __forceinline__ void p0_transpose_item(const float* W, int K, int N, bf16* WT, int row_off, LAS float* scr, int item, int lane) {
    const int nblk = N / 32, kb = item / nblk, nb = item % nblk, k0 = 64 * kb, n0 = 32 * nb;
    float tv[32];
#pragma unroll
    for (int i = 0; i < 32; ++i) { const int kk = 2 * i + (lane >> 5); tv[i] = W[(size_t)(k0 + kk) * N + n0 + (lane & 31)]; }
#pragma unroll
    for (int i = 0; i < 32; ++i) { const int kk = 2 * i + (lane >> 5); scr[kk * 33 + (lane & 31)] = tv[i]; }
    LDS_WAIT(); asm volatile("" ::: "memory");
    const int c = lane & 7;
#pragma unroll
    for (int j = 0; j < 4; ++j) { const int n = (lane >> 3) + 8 * j; const LAS float* s = scr + (8 * c) * 33 + n;
        v4u o; o.x = pk2(s[0 * 33], s[1 * 33]); o.y = pk2(s[2 * 33], s[3 * 33]); o.z = pk2(s[4 * 33], s[5 * 33]); o.w = pk2(s[6 * 33], s[7 * 33]);
        *(v4u*)(WT + (size_t)(row_off + n0 + n) * K + k0 + 8 * c) = o; }
    LDS_WAIT(); asm volatile("" ::: "memory");
}
__device__ __forceinline__ void p0_cvt(const float* src, bf16* dst, size_t n8, size_t gt, size_t ngt) {
    for (size_t i = gt; i < n8; i += 4 * ngt) {
        f32x4 a[4], b[4];
#pragma unroll
        for (int r = 0; r < 4; ++r) { const size_t j = (i + r * ngt < n8) ? i + r * ngt : i; a[r] = *(const f32x4*)(src + j * 8); b[r] = *(const f32x4*)(src + j * 8 + 4); }
#pragma unroll
        for (int r = 0; r < 4; ++r) {
            if (i + r * ngt < n8) {
                v4u w; w.x = pk2(a[r][0], a[r][1]); w.y = pk2(a[r][2], a[r][3]); w.z = pk2(b[r][0], b[r][1]); w.w = pk2(b[r][2], b[r][3]);
                *(v4u*)(dst + (i + r * ngt) * 8) = w;
            }
        }
    }
}
__device__ __forceinline__ void p0_cvt8(const float* src, unsigned char* dst, size_t n16, float scale, size_t gt, size_t ngt) {
    for (size_t i = gt; i < n16; i += 4 * ngt) {
        f32x4 a[4][4];
#pragma unroll
        for (int r = 0; r < 4; ++r) { const size_t j = (i + r * ngt < n16) ? i + r * ngt : i;
#pragma unroll
            for (int c = 0; c < 4; ++c) a[r][c] = *(const f32x4*)(src + j * 16 + 4 * c); }
#pragma unroll
        for (int r = 0; r < 4; ++r) {
            if (i + r * ngt < n16) {
                v4u w;
#pragma unroll
                for (int c = 0; c < 4; ++c) {
                    const f32x4 q = a[r][c] * scale;
                    int x = __builtin_amdgcn_cvt_pk_fp8_f32(q[0], q[1], 0, false);
                    x = __builtin_amdgcn_cvt_pk_fp8_f32(q[2], q[3], x, true);
                    w[c] = (unsigned)x;
                }
                *(v4u*)(dst + (i + r * ngt) * 16) = w;
            }
        }
    }
}
__device__ __forceinline__ void table_filler(Frame& F, int layer, int which, int nwg) {
    const int rem = nwg % F.G;
    int k = F.bx, n = F.G;
    if (rem) { if (F.bx < rem) return; k = F.bx - rem; n = F.G - rem; }
    const float* src = inp(which ? IN_PV : IN_PU) + (size_t)layer * NEXP * D;
    unsigned char* dst = (unsigned char*)(F.ws + (which ? WS_PV : WS_PU)) + (size_t)layer * NEXP * D;
    p0_cvt8(src, dst, (size_t)NEXP * D / 16, which ? 16.f : 64.f, (size_t)k * 512 + F.tid, (size_t)n * 512);
}
__device__ __forceinline__ void phase_prologue(Frame& F) {
    unsigned char* ws = F.ws;
    const int gw = F.bx * NWAVES + F.wave, NGW = F.G * NWAVES;
    const size_t gt = (size_t)F.bx * 512 + F.tid, ngt = (size_t)F.G * 512;
    LAS float* scr = (LAS float*)(F.lds + F.wave * 16384);
    {
        constexpr int I_WIN = (1024 / 64) * (4096 / 32), I_WOUT = (2048 / 64) * (1024 / 32), I_SQ = (1024 / 64) * (1024 / 32), I_KV = (1024 / 64) * (256 / 32), I_PLE = (256 / 64) * (1024 / 32);
        constexpr int NIT = 2 * I_WIN + 2 * I_WOUT + 2 * I_SQ + I_KV + 2 * I_SQ + 4 * I_PLE + 4 * I_SQ;
        for (int it = gw; it < NIT; it += NGW) {
            int r = it;
            if (r < 2 * I_WIN) { const int l = r / I_WIN; p0_transpose_item(inp(IN_WIN) + (size_t)l * 1024 * 4096, 1024, 4096, (bf16*)(ws + WS_WIN) + (size_t)l * 4096 * 1024, 0, scr, r % I_WIN, F.lane); continue; } r -= 2 * I_WIN;
            if (r < 2 * I_WOUT) { const int l = r / I_WOUT; p0_transpose_item(inp(IN_WOUT) + (size_t)l * 2048 * 1024, 2048, 1024, (bf16*)(ws + WS_WOUT) + (size_t)l * 1024 * 2048, 0, scr, r % I_WOUT, F.lane); continue; } r -= 2 * I_WOUT;
            if (r < I_SQ) { p0_transpose_item(inp(IN_WQ), 1024, 1024, (bf16*)(ws + WS_WQKV), 0, scr, r, F.lane); continue; } r -= I_SQ;
            if (r < I_SQ) { p0_transpose_item(inp(IN_WQ) + (size_t)1024 * 1024, 1024, 1024, (bf16*)(ws + WS_WQ1), 0, scr, r, F.lane); continue; } r -= I_SQ;
            if (r < I_KV) { p0_transpose_item(inp(IN_WKV), 1024, 256, (bf16*)(ws + WS_WQKV), 1024, scr, r, F.lane); continue; } r -= I_KV;
            if (r < 2 * I_SQ) { const int l = r / I_SQ; p0_transpose_item(inp(IN_WO) + (size_t)l * 1024 * 1024, 1024, 1024, (bf16*)(ws + WS_WO) + (size_t)l * 1024 * 1024, 0, scr, r % I_SQ, F.lane); continue; } r -= 2 * I_SQ;
            if (r < 4 * I_PLE) { const int l = r / I_PLE; p0_transpose_item(inp(IN_PLEW) + (size_t)l * 256 * 1024, 256, 1024, (bf16*)(ws + WS_PLE) + (size_t)l * 1024 * 256, 0, scr, r % I_PLE, F.lane); continue; } r -= 4 * I_PLE;
            { const int l = r / I_SQ; p0_transpose_item(inp(IN_GW) + (size_t)l * 1024 * 1024, 1024, 1024, (bf16*)(ws + WS_GATE) + (size_t)l * 1024 * 1024, 0, scr, r % I_SQ, F.lane); }
        }
    }
    __syncthreads();
    {
        LAS float* sk = (LAS float*)F.lds;
        LAS float* wq = (LAS float*)(F.lds + 128 * 132 * 4);
        for (int it = F.bx; it < 1024; it += F.G) {
            const int l = it >> 8, hp = (it >> 4) & 15, dc = it & 15, p = hp & 1;
            const float* skg = inp(IN_SUBK) + ((size_t)(l * 2 + p) * 128) * 128;
            const float* wqg = inp(IN_PWQ) + (size_t)l * 1024 * 2048 + (size_t)(dc * 64) * 2048 + hp * 128;
            for (int i = F.tid; i < 128 * 32; i += 512) *(LAS f32x4*)(sk + (i >> 5) * 132 + (i & 31) * 4) = *(const f32x4*)(skg + (size_t)i * 4);
            for (int i = F.tid; i < 64 * 32; i += 512) *(LAS f32x4*)(wq + (i >> 5) * 132 + (i & 31) * 4) = *(const f32x4*)(wqg + (size_t)(i >> 5) * 2048 + (i & 31) * 4);
            __syncthreads();
            const int ng = F.tid & 31, dg = F.tid >> 5;
            float a[4][4];
#pragma unroll
            for (int ni = 0; ni < 4; ++ni)
#pragma unroll
                for (int di = 0; di < 4; ++di) a[ni][di] = 0.f;
            for (int c4 = 0; c4 < 32; ++c4) {
                f32x4 sv[4], wv[4];
#pragma unroll
                for (int ni = 0; ni < 4; ++ni) sv[ni] = *(const LAS f32x4*)(sk + (ng + 32 * ni) * 132 + 4 * c4);
#pragma unroll
                for (int di = 0; di < 4; ++di) wv[di] = *(const LAS f32x4*)(wq + (4 * dg + di) * 132 + 4 * c4);
#pragma unroll
                for (int ni = 0; ni < 4; ++ni)
#pragma unroll
                    for (int di = 0; di < 4; ++di)
                        a[ni][di] += (sv[ni][0] * wv[di][0] + sv[ni][1] * wv[di][1]) + (sv[ni][2] * wv[di][2] + sv[ni][3] * wv[di][3]);
            }
#pragma unroll
            for (int ni = 0; ni < 4; ++ni) {
                bf16* o = (bf16*)(ws + WS_WQK) + ((size_t)l * 2048 + hp * 128 + ng + 32 * ni) * 1024 + dc * 64 + 4 * dg;
                v2u w0; w0.x = pk2(a[ni][0], a[ni][1]); w0.y = pk2(a[ni][2], a[ni][3]);
                *(v2u*)o = w0;
            }
            __syncthreads();
        }
    }
    for (int l = 0; l < 4; ++l) {
        p0_cvt(inp(IN_PPR) + (size_t)l * TP * DPLE, (bf16*)(ws + WS_PBF) + (size_t)l * T * DPLE, (size_t)TP * DPLE / 8, gt, ngt);
        p0_cvt(inp(IN_PSA) + (size_t)l * TS * DPLE, (bf16*)(ws + WS_PBF) + ((size_t)l * T + TP) * DPLE, (size_t)TS * DPLE / 8, gt, ngt);
    }
    {
        bf16* hb = (bf16*)(ws + WS_HB);
        for (size_t i0 = gt; i0 < (size_t)T * D / 8; i0 += 4 * ngt) {
            f32x4 a[4], b[4];
#pragma unroll
            for (int r = 0; r < 4; ++r) { const size_t i = (i0 + r * ngt < (size_t)T * D / 8) ? i0 + r * ngt : i0;
                const float* src = (i < (size_t)TP * D / 8) ? inp(IN_XP) + i * 8 : inp(IN_XS) + (i * 8 - (size_t)TP * D);
                a[r] = *(const f32x4*)src; b[r] = *(const f32x4*)(src + 4); }
#pragma unroll
            for (int r = 0; r < 4; ++r) { const size_t i = i0 + r * ngt;
                if (i < (size_t)T * D / 8) {
                    v4u w; w.x = pk2(a[r][0], a[r][1]); w.y = pk2(a[r][2], a[r][3]); w.z = pk2(b[r][0], b[r][1]); w.w = pk2(b[r][2], b[r][3]);
                    *(v4u*)(hb + i * 8) = w;
                } }
        }
    }
    {
        bf16* wsb = (bf16*)(ws + WS_WSB);
        for (size_t i = gt; i < (size_t)2 * 2 * 8 * 128 * 128; i += ngt) {
            const int s = (int)(i & 127), t = (int)((i >> 7) & 127), g = (int)((i >> 14) & 7), var = (int)((i >> 17) & 1), l = (int)(i >> 18);
            const float* w = inp(IN_WS) + ((size_t)(l * 8 + g) * 128) * 128;
            float v;
            if (var == 0) v = (s <= t) ? w[t * 128 + s] : 0.f;
            else v = ((t >> 3) == (s >> 3) && (s & 7) <= (t & 7)) ? w[(t & 7) * 128 + (s & 7)] : 0.f;
            wsb[i] = (bf16)f2bf(v);
        }
    }
    for (size_t i = gt; i < (size_t)128 * 120 * 128 / 4; i += ngt) {
        const size_t e = i * 4, db = e / (120 * 128), rem = e % (120 * 128);
        *(f32x4*)(F.out + O_KS + db * 128 * 128 + rem) = *(const f32x4*)(inp(IN_CK) + db * 128 * 128 + 8 * 128 + rem);
        *(f32x4*)(F.out + O_VS + db * 128 * 128 + rem) = *(const f32x4*)(inp(IN_CV) + db * 128 * 128 + 8 * 128 + rem);
    }
}

__device__ __forceinline__ void phase_spatial(Frame& F, int layer) {
    unsigned char* ws = F.ws;
    const bf16* Z = (const bf16*)(ws + WS_Z);
    const float* stats = (const float*)(ws + WS_STATS);
    const float* lng = inp(IN_SLNG) + layer * DSGU; const float* lnb = inp(IN_SLNB) + layer * DSGU;
    const float* bs = inp(IN_BS) + layer * 8 * 128;
    const bf16* wsb = (const bf16*)(ws + WS_WSB) + (size_t)layer * 2 * 8 * 128 * 128;
    bf16* gated = (bf16*)(ws + WS_GATED);
    float* osgu = F.out + O_SGU + (size_t)layer * TS * DSGU;
    constexpr int VS = 576, WSS = 272;
    LAS unsigned char* Wl = F.lds + 128 * VS + 1024;
    LAS f32x2* sttab = (LAS f32x2*)(F.lds + 128 * VS);
    const int lane = F.lane, w = F.wave, fr = lane & 15, fq = lane >> 4, q4 = (lane & 15) >> 2, p4 = lane & 3;
    int wvar = -1;
    for (int unit = F.bx; unit < 136 * 8; unit += F.G) {
        const int mt = unit >> 3, g = unit & 7, tok0 = mt * 128; const bool samp = mt >= 128;
        f32x4 pr[4];
#pragma unroll
        for (int k = 0; k < 4; ++k) pr[k] = *(const f32x4*)(stats + (size_t)(tok0 + (F.tid >> 2)) * 64 + (F.tid & 3) * 16 + 4 * k);
        v4u raw[8];
#pragma unroll
        for (int i = 0; i < 8; ++i) { const int id = F.tid + 512 * i, s = id >> 5, ch = id & 31; raw[i] = *(const v4u*)(Z + (size_t)(tok0 + s) * 4096 + 2048 + g * 256 + ch * 8); }
        v4u uu[8];
#pragma unroll
        for (int tt = 0; tt < 8; ++tt) uu[tt] = *(const v4u*)(Z + (size_t)(tok0 + 16 * tt + fr) * 4096 + g * 256 + 32 * w + 8 * fq);
        if (wvar != (samp ? 8 : 0) + g) {
            wvar = (samp ? 8 : 0) + g;
            const bf16* wg = wsb + ((size_t)wvar * 128) * 128;
#pragma unroll
            for (int i = 0; i < 4; ++i) { const int id = F.tid + 512 * i, r = id >> 4, ch = id & 15; *(LAS v4u*)(Wl + r * WSS + ch * 16) = *(const v4u*)(wg + (size_t)r * 128 + ch * 8); }
        }
        {
            float s1 = 0.f, s2 = 0.f;
#pragma unroll
            for (int k = 0; k < 4; ++k) { s1 += pr[k][0]; s2 += pr[k][1]; s1 += pr[k][2]; s2 += pr[k][3]; }
            s1 += __builtin_bit_cast(float, __builtin_amdgcn_update_dpp(0, __builtin_bit_cast(int, s1), 0xB1, 0xF, 0xF, true));
            s2 += __builtin_bit_cast(float, __builtin_amdgcn_update_dpp(0, __builtin_bit_cast(int, s2), 0xB1, 0xF, 0xF, true));
            s1 += __builtin_bit_cast(float, __builtin_amdgcn_update_dpp(0, __builtin_bit_cast(int, s1), 0x4E, 0xF, 0xF, true));
            s2 += __builtin_bit_cast(float, __builtin_amdgcn_update_dpp(0, __builtin_bit_cast(int, s2), 0x4E, 0xF, 0xF, true));
            const float mean = s1 * (1.f / DSGU), var = fmaxf(s2 * (1.f / DSGU) - mean * mean, 0.f);
            if ((F.tid & 3) == 0) sttab[F.tid >> 2] = (f32x2){mean, __builtin_amdgcn_rsqf(var + LN_EPS)};
        }
        __syncthreads();
#pragma unroll
        for (int i = 0; i < 8; ++i) {
            const int id = F.tid + 512 * i, s = id >> 5, ch = id & 31, tok = tok0 + s, col = g * 256 + ch * 8;
            const f32x2 st = sttab[s];
            const float mean = st.x, rstd = st.y;
            const f32x4 g0 = *(const f32x4*)(lng + col), g1 = *(const f32x4*)(lng + col + 4), b0 = *(const f32x4*)(lnb + col), b1 = *(const f32x4*)(lnb + col + 4);
            f32x4 y0, y1;
            y0[0] = (bflo(raw[i].x) - mean) * rstd * g0[0] + b0[0]; y0[1] = (bfhi(raw[i].x) - mean) * rstd * g0[1] + b0[1];
            y0[2] = (bflo(raw[i].y) - mean) * rstd * g0[2] + b0[2]; y0[3] = (bfhi(raw[i].y) - mean) * rstd * g0[3] + b0[3];
            y1[0] = (bflo(raw[i].z) - mean) * rstd * g1[0] + b1[0]; y1[1] = (bfhi(raw[i].z) - mean) * rstd * g1[1] + b1[1];
            y1[2] = (bflo(raw[i].w) - mean) * rstd * g1[2] + b1[2]; y1[3] = (bfhi(raw[i].w) - mean) * rstd * g1[3] + b1[3];
            v4u o; o.x = pk2(y0[0], y0[1]); o.y = pk2(y0[2], y0[3]); o.z = pk2(y1[0], y1[1]); o.w = pk2(y1[2], y1[3]);
            *(LAS v4u*)(F.lds + s * VS + ch * 16) = o;
            if (samp) { float* op = osgu + (size_t)(tok - TP) * DSGU + col; *(f32x4*)op = y0; *(f32x4*)(op + 4) = y1; }
        }
        __syncthreads();
        f32x4 acc[8][2];
#pragma unroll
        for (int tt = 0; tt < 8; ++tt) { acc[tt][0] = (f32x4){0.f, 0.f, 0.f, 0.f}; acc[tt][1] = (f32x4){0.f, 0.f, 0.f, 0.f}; }
        const unsigned vbase = (unsigned)(uintptr_t)(F.lds) + (unsigned)((8 * fq + q4) * VS + (32 * w + 8 * p4) * 2);
#pragma unroll
        for (int ks = 0; ks < 4; ++ks) {
            s16x4 lo0, hi0, lo1, hi1;
            const unsigned a0 = vbase + ks * 32 * VS;
            asm volatile("ds_read_b64_tr_b16 %0, %4\n\tds_read_b64_tr_b16 %1, %4 offset:2304\n\tds_read_b64_tr_b16 %2, %4 offset:8\n\tds_read_b64_tr_b16 %3, %4 offset:2312\n\ts_waitcnt lgkmcnt(0)"
                         : "=&v"(lo0), "=&v"(hi0), "=&v"(lo1), "=&v"(hi1) : "v"(a0) : "memory");
            const bf16x8 vf0 = (bf16x8){lo0[0], lo0[1], lo0[2], lo0[3], hi0[0], hi0[1], hi0[2], hi0[3]};
            const bf16x8 vf1 = (bf16x8){lo1[0], lo1[1], lo1[2], lo1[3], hi1[0], hi1[1], hi1[2], hi1[3]};
#pragma unroll
            for (int tt = 0; tt < 8; ++tt) {
                if (16 * tt + 15 >= 32 * ks) {
                    const bf16x8 wf = *(const LAS bf16x8*)(Wl + (16 * tt + fr) * WSS + (32 * ks + 8 * fq) * 2);
                    acc[tt][0] = __builtin_amdgcn_mfma_f32_16x16x32_bf16(vf0, wf, acc[tt][0], 0, 0, 0);
                    acc[tt][1] = __builtin_amdgcn_mfma_f32_16x16x32_bf16(vf1, wf, acc[tt][1], 0, 0, 0);
                }
            }
        }
#pragma unroll
        for (int tt = 0; tt < 8; ++tt) {
            const int t = 16 * tt + fr, tok = tok0 + t;
            const float bias = bs[g * 128 + (samp ? (t & 7) : t)];
            const size_t col = (size_t)g * 256 + 32 * w + 8 * fq;
            v4u o;
            o.x = pk2(bflo(uu[tt].x) * (acc[tt][0][0] + bias), bfhi(uu[tt].x) * (acc[tt][0][1] + bias));
            o.y = pk2(bflo(uu[tt].y) * (acc[tt][0][2] + bias), bfhi(uu[tt].y) * (acc[tt][0][3] + bias));
            o.z = pk2(bflo(uu[tt].z) * (acc[tt][1][0] + bias), bfhi(uu[tt].z) * (acc[tt][1][1] + bias));
            o.w = pk2(bflo(uu[tt].w) * (acc[tt][1][2] + bias), bfhi(uu[tt].w) * (acc[tt][1][3] + bias));
            *(v4u*)(gated + (size_t)tok * DSGU + col) = o;
        }
        __syncthreads();
    }
}

__device__ __forceinline__ void phase_ln1(Frame& F, int layer, bf16* hb) {
    unsigned char* ws = F.ws;
    const bf16* pre = (const bf16*)(ws + WS_PRE);
    const float* gg = inp(IN_LN1G) + layer * D; const float* bb = inp(IN_LN1B) + layer * D;
    const int gw = F.bx * NWAVES + F.wave, NGW = F.G * NWAVES, lane = F.lane;
    f32x4 gv[4], bv[4];
#pragma unroll
    for (int j = 0; j < 4; ++j) { gv[j] = *(const f32x4*)(gg + 4 * lane + 256 * j); bv[j] = *(const f32x4*)(bb + 4 * lane + 256 * j); }
    for (int m0 = gw; m0 < T; m0 += 9 * NGW) {
        f32x4 v[9][4];
#pragma unroll
        for (int r = 0; r < 9; ++r) { const int m = (m0 + r * NGW < T) ? m0 + r * NGW : m0;
#pragma unroll
            for (int j = 0; j < 4; ++j) { const v2u pw = *(const v2u*)(pre + (size_t)m * D + 4 * lane + 256 * j); v[r][j] = (f32x4){bflo(pw.x), bfhi(pw.x), bflo(pw.y), bfhi(pw.y)}; } }
#pragma unroll
        for (int r = 0; r < 9; ++r) {
            const int m = m0 + r * NGW;
            float s = 0.f;
#pragma unroll
            for (int j = 0; j < 4; ++j) s += (v[r][j][0] + v[r][j][1]) + (v[r][j][2] + v[r][j][3]);
            const float mean = wave_sum(s) * (1.f / D); float s2 = 0.f;
#pragma unroll
            for (int j = 0; j < 4; ++j) { v[r][j] = v[r][j] - mean; s2 += (v[r][j][0] * v[r][j][0] + v[r][j][1] * v[r][j][1]) + (v[r][j][2] * v[r][j][2] + v[r][j][3] * v[r][j][3]); }
            const float rstd = __builtin_amdgcn_rsqf(wave_sum(s2) * (1.f / D) + LN_EPS);
            if (m < T) {
#pragma unroll
                for (int j = 0; j < 4; ++j) {
                    const f32x4 y = v[r][j] * rstd * gv[j] + bv[j];
                    v2u o; o.x = pk2(y[0], y[1]); o.y = pk2(y[2], y[3]);
                    *(v2u*)(hb + (size_t)m * D + 4 * lane + 256 * j) = o;
                }
            }
        }
    }
}

__device__ __forceinline__ unsigned kmaxf(unsigned x, unsigned y) { unsigned r; asm("v_max_f32 %0, %1, %2" : "=v"(r) : "v"(x), "v"(y)); return r; }
__device__ __forceinline__ unsigned kminf(unsigned x, unsigned y) { unsigned r; asm("v_min_f32 %0, %1, %2" : "=v"(r) : "v"(x), "v"(y)); return r; }
template <bool FK> __device__ __forceinline__ unsigned kmax(unsigned x, unsigned y) { if (FK) return kmaxf(x, y); return x > y ? x : y; }
template <bool FK> __device__ __forceinline__ void ce_desc(unsigned& x, unsigned& y) { unsigned hi, lo; if (FK) { hi = kmaxf(x, y); lo = kminf(x, y); } else { hi = x > y ? x : y; lo = x > y ? y : x; } x = hi; y = lo; }
template <bool FK> __device__ __forceinline__ void sort16(unsigned (&a)[16]) {
#define CE(i, j) ce_desc<FK>(a[i], a[j]);
    CE(0, 13) CE(1, 12) CE(2, 15) CE(3, 14) CE(4, 8) CE(5, 6) CE(7, 11) CE(9, 10)
    CE(0, 5) CE(1, 7) CE(2, 9) CE(3, 4) CE(6, 13) CE(8, 14) CE(10, 15) CE(11, 12)
    CE(0, 1) CE(2, 3) CE(4, 5) CE(6, 8) CE(7, 9) CE(10, 11) CE(12, 13) CE(14, 15)
    CE(0, 2) CE(1, 3) CE(4, 10) CE(5, 11) CE(6, 7) CE(8, 9) CE(12, 14) CE(13, 15)
    CE(1, 2) CE(3, 12) CE(4, 6) CE(5, 7) CE(8, 10) CE(9, 11) CE(13, 14)
    CE(1, 4) CE(2, 6) CE(5, 8) CE(7, 10) CE(9, 13) CE(11, 14)
    CE(2, 4) CE(3, 6) CE(9, 12) CE(11, 13)
    CE(3, 5) CE(6, 8) CE(7, 9) CE(10, 12)
    CE(3, 4) CE(5, 6) CE(7, 8) CE(9, 10) CE(11, 12)
    CE(6, 7) CE(8, 9)
#undef CE
}
template <bool FK> __device__ __forceinline__ void bitonic16(unsigned (&a)[16]) {
#pragma unroll
    for (int j = 8; j > 0; j >>= 1)
#pragma unroll
        for (int i = 0; i < 16; ++i) { const int l = i ^ j; if (l > i) ce_desc<FK>(a[i], a[l]); }
}
template <bool FK> __device__ __forceinline__ void merge16(unsigned (&top)[16], const unsigned (&g)[16]) {
#pragma unroll
    for (int i = 0; i < 16; ++i) top[i] = kmax<FK>(top[i], g[15 - i]);
    bitonic16<FK>(top);
}
__device__ __forceinline__ unsigned ld_sc(__amdgpu_buffer_rsrc_t SC, int n, unsigned bo) { return (unsigned)__builtin_amdgcn_raw_buffer_load_b32(SC, (int)bo, n * (T * 4), 0); }
template <int NB, bool DUAL> __device__ __forceinline__ void top16_of_128(__amdgpu_buffer_rsrc_t SC, unsigned bo, int p, unsigned (&t1)[16], unsigned (&t2)[16]) {
    unsigned nx[NB][16];
#pragma unroll
    for (int b = 0; b < NB; ++b)
#pragma unroll
        for (int i = 0; i < 16; ++i) nx[b][i] = ld_sc(SC, b * 16 + i, bo);
#pragma unroll 1
    for (int it = 0; it < 8 / NB; ++it) {
#pragma unroll
        for (int b = 0; b < NB; ++b) {
            const int grp = it * NB + b;
            unsigned g1[16], g2[16];
#pragma unroll
            for (int i = 0; i < 16; ++i) {
                const unsigned ix = (unsigned)(127 - (grp * 16 + i));
                if (DUAL) { g1[i] = (nx[b][i] << 16) | ix; g2[i] = (nx[b][i] & 0xffff0000u) | ix; }
                else g1[i] = (p ? (nx[b][i] & 0xffff0000u) : (nx[b][i] << 16)) | ix;
            }
            if (it + 1 < 8 / NB) {
#pragma unroll
                for (int i = 0; i < 16; ++i) nx[b][i] = ld_sc(SC, (grp + NB) * 16 + i, bo);
            }
            sort16<true>(g1); if (DUAL) sort16<true>(g2);
            if (b == 0 && it == 0) {
#pragma unroll
                for (int i = 0; i < 16; ++i) { t1[i] = g1[i]; if (DUAL) t2[i] = g2[i]; }
            } else { merge16<true>(t1, g1); if (DUAL) merge16<true>(t2, g2); }
        }
    }
}
__device__ __forceinline__ void phase_topk(Frame& F) {
    unsigned char* ws = F.ws;
    const __amdgpu_buffer_rsrc_t SC = __builtin_amdgcn_make_buffer_rsrc((void*)(ws + WS_SC), (short)0, 1024 * T * 4, 0x00020000);
    int* eidx = (int*)(ws + WS_EIDX); float* gwt = (float*)(ws + WS_GW);
    LAS unsigned char* ib = F.lds + F.tid * 32;
    const int tpb = (T + F.G - 1) / F.G, t0 = F.bx * tpb, cnt = (T - t0) < tpb ? (T - t0 > 0 ? T - t0 : 0) : tpb;
    const int nit = cnt * 8, left = nit > 512 ? nit - 512 : 0;
    const bool pairs = left > 0 && left <= 256;
    for (int rnd = 0; rnd < 2; ++rnd) {
        int it; bool act, wr; int pp = 0;
        if (rnd == 0) { it = F.tid; act = it < nit; wr = act; }
        else if (pairs) { it = 512 + (F.tid >> 1); pp = F.tid & 1; act = (F.tid >> 1) < left; wr = act && pp == 0; }
        else { it = 512 + F.tid; act = it < nit; wr = act; }
        if (rnd == 1 && left == 0) break;
        if (__builtin_amdgcn_readfirstlane(__ballot(act) == 0ull ? 1 : 0)) continue;
        const int itc = act ? it : 0;
        const int h = itc / cnt, t = t0 + itc % cnt;
        unsigned l1[16], l2[16];
        const unsigned bo = (unsigned)((h * 128) * T + t) * 4u;
        if (rnd == 1 && pairs) {
            top16_of_128<1, false>(SC, bo, pp, l1, l2);
#pragma unroll
            for (int i = 0; i < 16; ++i) l2[i] = (unsigned)__builtin_amdgcn_update_dpp(0, (int)l1[i], 0xB1, 0xF, 0xF, true);
            if (pp) {
#pragma unroll
                for (int i = 0; i < 16; ++i) { const unsigned x = l1[i]; l1[i] = l2[i]; l2[i] = x; }
            }
        } else {
            top16_of_128<1, true>(SC, bo, 0, l1, l2);
        }
        float v1[16], v2[16];
#pragma unroll
        for (int i = 0; i < 16; ++i) { v1[i] = __builtin_bit_cast(float, l1[i] & ~127u); v2[i] = __builtin_bit_cast(float, l2[i] & ~127u); ib[i] = (unsigned char)l1[i]; ib[16 + i] = (unsigned char)l2[i];     }
#define CK(a, b) ((__builtin_bit_cast(unsigned, v1[a] + v2[b]) & ~255u) | (unsigned)(255 - (16 * (a) + (b))))
        unsigned c[3][16];
#pragma unroll
        for (int i = 0; i < 16; ++i) c[0][i] = CK(0, i);
#pragma unroll
        for (int i = 0; i < 8; ++i) { c[1][i] = CK(1, i); c[1][8 + i] = CK(15 - i, 0); }
        bitonic16<true>(c[1]);
        c[2][0] = CK(2, 0); c[2][1] = CK(2, 1); c[2][2] = CK(2, 2); c[2][3] = CK(2, 3); c[2][4] = CK(2, 4);
        c[2][5] = CK(3, 0); c[2][6] = CK(3, 1); c[2][7] = CK(3, 2); c[2][8] = CK(3, 3);
        c[2][9] = CK(4, 0); c[2][10] = CK(4, 1); c[2][11] = CK(4, 2);
        c[2][12] = CK(5, 0); c[2][13] = CK(5, 1); c[2][14] = CK(6, 0); c[2][15] = CK(6, 1);
        sort16<true>(c[2]);
        merge16<true>(c[0], c[1]); merge16<true>(c[0], c[2]);
        c[0][15] = kmax<true>(c[0][15], CK(7, 0)); c[0][14] = kmax<true>(c[0][14], CK(7, 1));
#undef CK
        bitonic16<true>(c[0]);
        float e[16], sum = 0.f; const float mx = __builtin_bit_cast(float, c[0][0] & ~255u);
#pragma unroll
        for (int i = 0; i < 16; ++i) { e[i] = fexp2((__builtin_bit_cast(float, c[0][i] & ~255u) - mx) * 1.4426950408889634f); sum += e[i]; }
        const float inv = 1.0f / sum;
        int* eo = eidx + (size_t)t * 128 + h * 16; float* go = gwt + (size_t)t * 128 + h * 16;
        LDS_WAIT();
#pragma unroll
        for (int i = 0; i < 16; ++i) {
            const unsigned ab = 255u - (c[0][i] & 255u);
            const int r1 = ib[ab >> 4], r2 = ib[16 + (ab & 15u)];
            if (wr) { eo[i] = 16383 - (r1 * 128 + r2); go[i] = e[i] * inv; }
        }
        LDS_WAIT();
    }
}

constexpr float PU_SCALE = 64.f, PV_SCALE = 16.f, Y_AK = 4.f;
typedef _Float16 h2v __attribute__((ext_vector_type(2)));
constexpr int G_NR = 64, G_SH = 8;
typedef unsigned u2v __attribute__((ext_vector_type(2)));
__device__ __forceinline__ float reduce4(float p0, float p1, float p2, float p3) {
    const u2v r01 = __builtin_amdgcn_permlane32_swap(__builtin_bit_cast(unsigned, p0), __builtin_bit_cast(unsigned, p1), false, false);
    const u2v r23 = __builtin_amdgcn_permlane32_swap(__builtin_bit_cast(unsigned, p2), __builtin_bit_cast(unsigned, p3), false, false);
    const unsigned a0 = r01.x, a1 = r01.y, b0 = r23.x, b1 = r23.y;
    const float s01 = __builtin_bit_cast(float, a0) + __builtin_bit_cast(float, a1), s23 = __builtin_bit_cast(float, b0) + __builtin_bit_cast(float, b1);
    const u2v q = __builtin_amdgcn_permlane16_swap(__builtin_bit_cast(unsigned, s01), __builtin_bit_cast(unsigned, s23), false, false);
    const unsigned q0 = q.x, q1 = q.y;
    return row16_sum(__builtin_bit_cast(float, q0) + __builtin_bit_cast(float, q1));
}
__device__ __forceinline__ void gsort2(unsigned& ka0, unsigned& kb0, unsigned& ka1, unsigned& kb1, int lane) {
#pragma unroll
    for (int k = 2; k <= 128; k <<= 1)
#pragma unroll
        for (int j = k >> 1; j > 0; j >>= 1)
#pragma unroll
            for (int s = 0; s < 2; ++s) {
                unsigned& ka = s ? ka1 : ka0; unsigned& kb = s ? kb1 : kb0;
                if (j == 64) { const unsigned lo = ka < kb ? ka : kb, hi = ka < kb ? kb : ka; ka = lo; kb = hi; }
                else {
                    const unsigned pa = (unsigned)__builtin_amdgcn_ds_bpermute((lane ^ j) << 2, (int)ka), pb = (unsigned)__builtin_amdgcn_ds_bpermute((lane ^ j) << 2, (int)kb);
                    const bool lower = (lane & j) == 0;
                    const bool upa = (k >= 128) ? true : ((lane & k) == 0);
                    const bool upb = (k >= 128) ? true : ((k == 64) ? false : ((lane & k) == 0));
                    const unsigned mna = ka < pa ? ka : pa, mxa = ka < pa ? pa : ka;
                    const unsigned mnb = kb < pb ? kb : pb, mxb = kb < pb ? pb : kb;
                    ka = (upa == lower) ? mna : mxa; kb = (upb == lower) ? mnb : mxb;
                }
            }
}
__device__ __forceinline__ void gsort4(unsigned (&ka_)[4], unsigned (&kb_)[4], int lane) {
#pragma unroll
    for (int k = 2; k <= 128; k <<= 1)
#pragma unroll
        for (int j = k >> 1; j > 0; j >>= 1) {
            if (j == 64) {
#pragma unroll
                for (int s = 0; s < 4; ++s) { const unsigned lo = ka_[s] < kb_[s] ? ka_[s] : kb_[s], hi = ka_[s] < kb_[s] ? kb_[s] : ka_[s]; ka_[s] = lo; kb_[s] = hi; }
            } else {
                unsigned pa[4], pb[4];
#pragma unroll
                for (int s = 0; s < 4; ++s) { pa[s] = (unsigned)__builtin_amdgcn_ds_bpermute((lane ^ j) << 2, (int)ka_[s]); pb[s] = (unsigned)__builtin_amdgcn_ds_bpermute((lane ^ j) << 2, (int)kb_[s]); }
                const bool lower = (lane & j) == 0;
                const bool upa = (k >= 128) ? true : ((lane & k) == 0);
                const bool upb = (k >= 128) ? true : ((k == 64) ? false : ((lane & k) == 0));
#pragma unroll
                for (int s = 0; s < 4; ++s) {
                    const unsigned mna = ka_[s] < pa[s] ? ka_[s] : pa[s], mxa = ka_[s] < pa[s] ? pa[s] : ka_[s];
                    const unsigned mnb = kb_[s] < pb[s] ? kb_[s] : pb[s], mxb = kb_[s] < pb[s] ? pb[s] : kb_[s];
                    ka_[s] = (upa == lower) ? mna : mxa; kb_[s] = (upb == lower) ? mnb : mxb;
                }
            }
        }
}
constexpr int GNS = 9, GNV = 4;
__device__ __forceinline__ void phase_gather(Frame& F, int layer, bf16* hb, bool dry = false) {
    unsigned char* ws = F.ws;
    const int* eidx = (const int*)(ws + WS_EIDX); const float* gwt = (const float*)(ws + WS_GW);
    const float* g2 = inp(IN_LN2G) + layer * D; const float* b2 = inp(IN_LN2B) + layer * D;
    const int tpb = (T + F.G - 1) / F.G, t0 = F.bx * tpb, cnt = (T - t0) < tpb ? (T - t0 > 0 ? T - t0 : 0) : tpb;
    const int lane = F.lane;
    const __amdgpu_buffer_rsrc_t srdU = __builtin_amdgcn_make_buffer_rsrc((void*)(ws + WS_PU + (size_t)layer * NEXP * D), (short)0, NEXP * D, 0x00020000);
    const __amdgpu_buffer_rsrc_t srdV = __builtin_amdgcn_make_buffer_rsrc((void*)(ws + WS_PV + (size_t)layer * NEXP * D), (short)0, NEXP * D, 0x00020000);
    const unsigned l16 = (unsigned)lane * 16u;
    const bool dg = (lane >> 4) == ((lane & 15) >> 2);
    const int ridx = (int)(reduce4(1.f / 64.f, 2.f / 64.f, 3.f / 64.f, 4.f / 64.f) + 0.5f) - 1;
    const int pos0 = __builtin_ctzll(__ballot(ridx == 0)), pos1 = __builtin_ctzll(__ballot(ridx == 1)), pos2 = __builtin_ctzll(__ballot(ridx == 2)), pos3 = __builtin_ctzll(__ballot(ridx == 3));
    LAS unsigned* aL = (LAS unsigned*)(F.lds + F.wave * 16384);
    const int kmax = (cnt + NWAVES - 1) / NWAVES;
    const int npass = (kmax + GNS - 1) / GNS;
#pragma unroll 1
    for (int pass = 0; pass < npass; ++pass) {
        const int tb = F.wave + NWAVES * GNS * pass;
        int nv = (cnt - tb + NWAVES - 1) / NWAVES; nv = nv < 0 ? 0 : (nv > GNS ? GNS : nv);
        nv = __builtin_amdgcn_readfirstlane(nv);
        LAS unsigned* kL = (LAS unsigned*)(F.lds + F.wave * 16384 + 8192);
        v4u uA[4], uB[4];
#define G_SYNC(it) do { if ((it) && !((it) & 3)) __syncthreads(); } while (0)
#define G_FILL(SR, s, X, st) do { unsigned lo_ = l16; asm volatile("" : "+v"(lo_));     \
            _Pragma("unroll") for (int i_ = 0; i_ < 4; ++i_) { \
            const int e_ = (int)((unsigned)__builtin_amdgcn_readlane((int)ka[s], 4 * (st) + i_) >> 16); \
            u##X[i_] = __builtin_amdgcn_raw_buffer_load_b128(SR, (int)lo_, e_ * D, 0); } } while (0)
        {
            long xq[GNS][2];
            unsigned ka[GNS + 1], kb[GNS + 1];
#pragma unroll
            for (int s = 0; s < GNS; ++s) {
                const int t = (s < nv) ? t0 + tb + NWAVES * s : t0;
                const v4u x0 = *(const v4u*)(hb + (size_t)t * D + lane * 16), x1 = *(const v4u*)(hb + (size_t)t * D + lane * 16 + 8);
                int q0 = __builtin_amdgcn_cvt_pk_fp8_f32(bflo(x0.x), bfhi(x0.x), 0, false); q0 = __builtin_amdgcn_cvt_pk_fp8_f32(bflo(x0.y), bfhi(x0.y), q0, true);
                int q1 = __builtin_amdgcn_cvt_pk_fp8_f32(bflo(x0.z), bfhi(x0.z), 0, false); q1 = __builtin_amdgcn_cvt_pk_fp8_f32(bflo(x0.w), bfhi(x0.w), q1, true);
                int q2 = __builtin_amdgcn_cvt_pk_fp8_f32(bflo(x1.x), bfhi(x1.x), 0, false); q2 = __builtin_amdgcn_cvt_pk_fp8_f32(bflo(x1.y), bfhi(x1.y), q2, true);
                int q3 = __builtin_amdgcn_cvt_pk_fp8_f32(bflo(x1.z), bfhi(x1.z), 0, false); q3 = __builtin_amdgcn_cvt_pk_fp8_f32(bflo(x1.w), bfhi(x1.w), q3, true);
                xq[s][0] = (long)(((unsigned long long)(unsigned)q1 << 32) | (unsigned)q0); xq[s][1] = (long)(((unsigned long long)(unsigned)q3 << 32) | (unsigned)q2);
                const _Float16 w0 = (_Float16)gwt[(size_t)t * 128 + lane], w1 = (_Float16)gwt[(size_t)t * 128 + 64 + lane];
                ka[s] = ((unsigned)eidx[(size_t)t * 128 + lane] << 16) | (unsigned)__builtin_bit_cast(unsigned short, w0);
                kb[s] = ((unsigned)eidx[(size_t)t * 128 + 64 + lane] << 16) | (unsigned)__builtin_bit_cast(unsigned short, w1);
            }
            ka[GNS] = 0u; kb[GNS] = 0u;
            if (nv > 0) { unsigned a4[4] = {ka[0], ka[1], ka[2], ka[3]}, b4[4] = {kb[0], kb[1], kb[2], kb[3]}; gsort4(a4, b4, lane);
#pragma unroll
                for (int z = 0; z < 4; ++z) { ka[z] = a4[z]; kb[z] = b4[z]; } }
            if (nv > 4) { unsigned a4[4] = {ka[4], ka[5], ka[6], ka[7]}, b4[4] = {kb[4], kb[5], kb[6], kb[7]}; gsort4(a4, b4, lane);
#pragma unroll
                for (int z = 0; z < 4; ++z) { ka[4 + z] = a4[z]; kb[4 + z] = b4[z]; } }
            if (nv > 8) gsort2(ka[8], kb[8], ka[9], kb[9], lane);
#pragma unroll
            for (int z = 0; z < GNS; ++z) { kL[z * 128 + lane] = ka[z]; kL[z * 128 + 64 + lane] = kb[z]; }
#define G_STEPU(s, X, st) do { float pt_[4]; f32x4 ac_[4]; \
            _Pragma("unroll") for (int i_ = 0; i_ < 4; ++i_) { \
                ac_[i_] = __builtin_amdgcn_mfma_f32_16x16x32_fp8_fp8((long)(((unsigned long long)u##X[i_][1] << 32) | u##X[i_][0]), xq[s][0], (f32x4){0.f, 0.f, 0.f, 0.f}, 0, 0, 0); \
                ac_[i_] = __builtin_amdgcn_mfma_f32_16x16x32_fp8_fp8((long)(((unsigned long long)u##X[i_][3] << 32) | u##X[i_][2]), xq[s][1], ac_[i_], 0, 0, 0); } \
            const unsigned short gh_ = (unsigned short)__builtin_amdgcn_ds_bpermute((4 * (st) + ridx) << 2, (int)ka[s]); const float gv_ = (float)__builtin_bit_cast(_Float16, gh_);     \
            _Pragma("unroll") for (int i_ = 0; i_ < 4; ++i_) { \
                const float dv_ = (lane & 2) ? ((lane & 1) ? ac_[i_][3] : ac_[i_][2]) : ((lane & 1) ? ac_[i_][1] : ac_[i_][0]); \
                pt_[i_] = dg ? dv_ : 0.f; } \
            const float tw_ = reduce4(pt_[0], pt_[1], pt_[2], pt_[3]);     \
            const _Float16 ah_ = (_Float16)(gelu_tanh(tw_ * (1.f / PU_SCALE)) * gv_ * Y_AK); \
            const h2v ap_ = {ah_, ah_}; \
            if ((lane & 15) == 0) aL[(s) * 128 + half * 64 + 4 * (st) + ridx] = __builtin_bit_cast(unsigned, ap_); } while (0)
            h2v y8[8]; v4u vA[4], vB[4];
#pragma unroll
            for (int p = 0; p < 8; ++p) y8[p] = (h2v){(_Float16)0.f, (_Float16)0.f};
#define G_CVH8(W, HI) __builtin_bit_cast(h2v, __builtin_amdgcn_cvt_scalef32_pk_f16_fp8((W), 1.0f, (HI)))
#define G_FILL8(X, st) do { unsigned lo_ = l16; asm volatile("" : "+v"(lo_)); \
            _Pragma("unroll") for (int i_ = 0; i_ < 4; ++i_) { \
            const int e_ = (int)((unsigned)__builtin_amdgcn_readlane((int)ka[8], 4 * (st) + i_) >> 16); \
            u##X[i_] = __builtin_amdgcn_raw_buffer_load_b128(srdU, (int)lo_, e_ * D, 0); v##X[i_] = __builtin_amdgcn_raw_buffer_load_b128(srdV, (int)lo_, e_ * D, 0); } } while (0)
#define G_STEPU8(X, st) do { float pt_[4]; f32x4 ac_[4]; \
            _Pragma("unroll") for (int i_ = 0; i_ < 4; ++i_) { \
                ac_[i_] = __builtin_amdgcn_mfma_f32_16x16x32_fp8_fp8((long)(((unsigned long long)u##X[i_][1] << 32) | u##X[i_][0]), xq[8][0], (f32x4){0.f, 0.f, 0.f, 0.f}, 0, 0, 0); \
                ac_[i_] = __builtin_amdgcn_mfma_f32_16x16x32_fp8_fp8((long)(((unsigned long long)u##X[i_][3] << 32) | u##X[i_][2]), xq[8][1], ac_[i_], 0, 0, 0); } \
            const unsigned short gh_ = (unsigned short)__builtin_amdgcn_ds_bpermute((4 * (st) + ridx) << 2, (int)ka[8]); const float gv_ = (float)__builtin_bit_cast(_Float16, gh_); \
            _Pragma("unroll") for (int i_ = 0; i_ < 4; ++i_) { \
                const float dv_ = (lane & 2) ? ((lane & 1) ? ac_[i_][3] : ac_[i_][2]) : ((lane & 1) ? ac_[i_][1] : ac_[i_][0]); \
                pt_[i_] = dg ? dv_ : 0.f; } \
            const float tw_ = reduce4(pt_[0], pt_[1], pt_[2], pt_[3]); \
            const _Float16 ah_ = (_Float16)(gelu_tanh(tw_ * (1.f / PU_SCALE)) * gv_ * Y_AK); \
            const h2v ap_ = {ah_, ah_}; const int av_ = __builtin_bit_cast(int, ap_); \
            _Pragma("unroll") for (int i_ = 0; i_ < 4; ++i_) { \
                const h2v a2_ = __builtin_bit_cast(h2v, __builtin_amdgcn_readlane(av_, i_ == 0 ? pos0 : i_ == 1 ? pos1 : i_ == 2 ? pos2 : pos3)); \
                _Pragma("unroll") for (int w_ = 0; w_ < 4; ++w_) { \
                    y8[2 * w_] = __builtin_elementwise_fma(G_CVH8(v##X[i_][w_], false), a2_, y8[2 * w_]); \
                    y8[2 * w_ + 1] = __builtin_elementwise_fma(G_CVH8(v##X[i_][w_], true), a2_, y8[2 * w_ + 1]); } } } while (0)
#pragma unroll 1
            for (int half = 0; half < 2; ++half) {
                __syncthreads();
                if (nv != 8) {
                    G_FILL(srdU, 0, A, 0);
#pragma unroll 1
                    for (int it = 0; it < 16; it += 2) {
                        G_SYNC(it);
                        G_FILL(srdU, 1, B, it); G_STEPU(0, A, it); G_FILL(srdU, 2, A, it); G_STEPU(1, B, it); G_FILL(srdU, 3, B, it); G_STEPU(2, A, it);
                        G_FILL(srdU, 4, A, it); G_STEPU(3, B, it); G_FILL(srdU, 5, B, it); G_STEPU(4, A, it); G_FILL(srdU, 6, A, it); G_STEPU(5, B, it);
                        G_FILL(srdU, 7, B, it); G_STEPU(6, A, it); G_FILL8(A, it); G_STEPU(7, B, it); G_FILL(srdU, 0, B, it + 1); G_STEPU8(A, it);
                        G_FILL(srdU, 1, A, it + 1); G_STEPU(0, B, it + 1); G_FILL(srdU, 2, B, it + 1); G_STEPU(1, A, it + 1); G_FILL(srdU, 3, A, it + 1); G_STEPU(2, B, it + 1);
                        G_FILL(srdU, 4, B, it + 1); G_STEPU(3, A, it + 1); G_FILL(srdU, 5, A, it + 1); G_STEPU(4, B, it + 1); G_FILL(srdU, 6, B, it + 1); G_STEPU(5, A, it + 1);
                        G_FILL(srdU, 7, A, it + 1); G_STEPU(6, B, it + 1); G_FILL8(B, it + 1); G_STEPU(7, A, it + 1);
                        if (it < 14) G_FILL(srdU, 0, A, it + 2);
                        G_STEPU8(B, it + 1);
                    }
                } else {
                    G_FILL(srdU, 0, A, 0);
#pragma unroll 1
                    for (int it = 0; it < 16; ++it) {
                        G_SYNC(it);
                        G_FILL(srdU, 1, B, it); G_STEPU(0, A, it); G_FILL(srdU, 2, A, it); G_STEPU(1, B, it); G_FILL(srdU, 3, B, it); G_STEPU(2, A, it);
                        G_FILL(srdU, 4, A, it); G_STEPU(3, B, it); G_FILL(srdU, 5, B, it); G_STEPU(4, A, it); G_FILL(srdU, 6, A, it); G_STEPU(5, B, it);
                        G_FILL(srdU, 7, B, it); G_STEPU(6, A, it);
                        if (it < 15) G_FILL(srdU, 0, A, it + 1);
                        G_STEPU(7, B, it);
                    }
                }
#pragma unroll
                for (int s = 0; s < GNS; ++s) ka[s] = kb[s];
            }
#undef G_STEPU
#undef G_STEPU8
#undef G_FILL8
#undef G_CVH8
            if (nv == GNS) {
                const int t = t0 + tb + NWAVES * (GNS - 1);
                float sm = 0.f; f32x2 y[8];
                { const v4u x0 = *(const v4u*)(hb + (size_t)t * D + lane * 16), x1 = *(const v4u*)(hb + (size_t)t * D + lane * 16 + 8);
                  const f32x2 xr[8] = {(f32x2){bflo(x0.x), bfhi(x0.x)}, (f32x2){bflo(x0.y), bfhi(x0.y)}, (f32x2){bflo(x0.z), bfhi(x0.z)}, (f32x2){bflo(x0.w), bfhi(x0.w)},
                                       (f32x2){bflo(x1.x), bfhi(x1.x)}, (f32x2){bflo(x1.y), bfhi(x1.y)}, (f32x2){bflo(x1.z), bfhi(x1.z)}, (f32x2){bflo(x1.w), bfhi(x1.w)}};
#pragma unroll
                  for (int p = 0; p < 8; ++p) { y[p] = xr[p] * ALPHA + (f32x2){(float)y8[p].x, (float)y8[p].y} * (1.f / (PV_SCALE * Y_AK)); sm += y[p].x + y[p].y; } }
                const float mean = wave_sum(sm) * (1.f / D);
                float s2 = 0.f;
#pragma unroll
                for (int p = 0; p < 8; ++p) { y[p] = y[p] - mean; s2 += y[p].x * y[p].x + y[p].y * y[p].y; }
                const float rstd = __builtin_amdgcn_rsqf(wave_sum(s2) * (1.f / D) + LN_EPS);
                if (dry) asm volatile("" :: "v"(rstd));
                if (!dry) {
                    const size_t ro = (size_t)t * D + lane * 16;
                    unsigned wb[8];
#pragma unroll
                    for (int c = 0; c < 4; ++c) {
                        const f32x4 ga = *(const f32x4*)(g2 + lane * 16 + 4 * c), ba = *(const f32x4*)(b2 + lane * 16 + 4 * c);
                        f32x4 o;
                        o[0] = y[2 * c].x * rstd * ga[0] + ba[0]; o[1] = y[2 * c].y * rstd * ga[1] + ba[1];
                        o[2] = y[2 * c + 1].x * rstd * ga[2] + ba[2]; o[3] = y[2 * c + 1].y * rstd * ga[3] + ba[3];
                        wb[2 * c] = pk2(o[0], o[1]); wb[2 * c + 1] = pk2(o[2], o[3]);
                    }
                    *(v4u*)(hb + ro) = (v4u){wb[0], wb[1], wb[2], wb[3]}; *(v4u*)(hb + ro + 8) = (v4u){wb[4], wb[5], wb[6], wb[7]};
                }
            }
        }
#define G_CVH(W, HI) __builtin_bit_cast(h2v, __builtin_amdgcn_cvt_scalef32_pk_f16_fp8((W), 1.0f, (HI)))
#define G_STEPV(s, X, st) do { const v4u a4_ = *(const LAS v4u*)(aL + sg[s] * 128 + half * 64 + 4 * (st));     \
            _Pragma("unroll") for (int i_ = 0; i_ < 4; ++i_) { \
                const h2v a2_ = __builtin_bit_cast(h2v, __builtin_amdgcn_readfirstlane((int)a4_[i_])); \
                _Pragma("unroll") for (int w_ = 0; w_ < 4; ++w_) { \
                    yh[s][2 * w_] = __builtin_elementwise_fma(G_CVH(u##X[i_][w_], false), a2_, yh[s][2 * w_]); \
                    yh[s][2 * w_ + 1] = __builtin_elementwise_fma(G_CVH(u##X[i_][w_], true), a2_, yh[s][2 * w_ + 1]); } } } while (0)
#pragma unroll 1
        for (int vp = 0; vp < (GNS - 1 + GNV - 1) / GNV; ++vp) {
            const int sb = GNV * vp;
            int nvv = (nv < GNS - 1 ? nv : GNS - 1) - sb; nvv = nvv < 0 ? 0 : (nvv > GNV ? GNV : nvv);
            int sg[GNV];
#pragma unroll
            for (int s = 0; s < GNV; ++s) sg[s] = (sb + s < GNS - 1) ? sb + s : GNS - 2;
            unsigned ka[GNV]; h2v yh[GNV][8];
#pragma unroll
            for (int s = 0; s < GNV; ++s)
#pragma unroll
                for (int p = 0; p < 8; ++p) yh[s][p] = (h2v){(_Float16)0.f, (_Float16)0.f};
            if (nvv >= 2) {
                unsigned kb[GNV];
#pragma unroll
                for (int s = 0; s < GNV; ++s) { ka[s] = kL[sg[s] * 128 + lane]; kb[s] = kL[sg[s] * 128 + 64 + lane]; }
                __syncthreads();
                const int half = 0;
#define G_FILLH(s, X, st) do { unsigned lo_ = l16; asm volatile("" : "+v"(lo_)); const unsigned kk_ = ((st) & 16) ? kb[s] : ka[s]; \
            _Pragma("unroll") for (int i_ = 0; i_ < 4; ++i_) { \
            const int e_ = (int)((unsigned)__builtin_amdgcn_readlane((int)kk_, (4 * (st) + i_) & 63) >> 16); \
            u##X[i_] = __builtin_amdgcn_raw_buffer_load_b128(srdV, (int)lo_, e_ * D, 0); } } while (0)
                v4u uC[4], uD[4];
                G_FILLH(0, A, 0); G_FILLH(1, B, 0); G_FILLH(2, C, 0); G_FILLH(3, D, 0);
#pragma unroll 1
                for (int it = 0; it < 32; ++it) {
                    const int itn = it < 31 ? it + 1 : 31;
                    G_SYNC(it);
                    G_STEPV(0, A, it); G_FILLH(0, A, itn);
                    G_STEPV(1, B, it); G_FILLH(1, B, itn);
                    G_STEPV(2, C, it); G_FILLH(2, C, itn);
                    G_STEPV(3, D, it); G_FILLH(3, D, itn);
                }
#undef G_FILLH
            } else
#pragma unroll 1
            for (int half = 0; half < 2; ++half) {
#pragma unroll
                for (int s = 0; s < GNV; ++s) ka[s] = kL[sg[s] * 128 + half * 64 + lane];
                __syncthreads();
                if (nvv == 0) { __syncthreads(); __syncthreads(); __syncthreads(); }
                else if (nvv == 1) {
                    G_FILL(srdV, 0, A, 0);
#pragma unroll 1
                    for (int it = 0; it < 16; it += 2) {
                        G_SYNC(it);
                        G_FILL(srdV, 0, B, it + 1); G_STEPV(0, A, it);
                        if (it < 14) G_FILL(srdV, 0, A, it + 2);
                        G_STEPV(0, B, it + 1);
                    }
                } else {
                    v4u uC[4], uD[4];
                    G_FILL(srdV, 0, A, 0); G_FILL(srdV, 1, B, 0); G_FILL(srdV, 2, C, 0); G_FILL(srdV, 3, D, 0);
#pragma unroll 1
                    for (int it = 0; it < 16; ++it) {
                        const int itn = it < 15 ? it + 1 : 15;
                        G_SYNC(it);
                        G_STEPV(0, A, it); G_FILL(srdV, 0, A, itn);
                        G_STEPV(1, B, it); G_FILL(srdV, 1, B, itn);
                        G_STEPV(2, C, it); G_FILL(srdV, 2, C, itn);
                        G_STEPV(3, D, it); G_FILL(srdV, 3, D, itn);
                    }
                }
            }
            f32x4 g2q[4], b2q[4];
#pragma unroll
            for (int c = 0; c < 4; ++c) { g2q[c] = *(const f32x4*)(g2 + lane * 16 + 4 * c); b2q[c] = *(const f32x4*)(b2 + lane * 16 + 4 * c); }
#pragma unroll
            for (int s = 0; s < GNV; ++s) {
                const int t = (s < nvv) ? t0 + tb + NWAVES * (sb + s) : t0;
                float sm = 0.f; f32x2 y[8];
                { const v4u x0 = *(const v4u*)(hb + (size_t)t * D + lane * 16), x1 = *(const v4u*)(hb + (size_t)t * D + lane * 16 + 8);
                  const f32x2 xr[8] = {(f32x2){bflo(x0.x), bfhi(x0.x)}, (f32x2){bflo(x0.y), bfhi(x0.y)}, (f32x2){bflo(x0.z), bfhi(x0.z)}, (f32x2){bflo(x0.w), bfhi(x0.w)},
                                       (f32x2){bflo(x1.x), bfhi(x1.x)}, (f32x2){bflo(x1.y), bfhi(x1.y)}, (f32x2){bflo(x1.z), bfhi(x1.z)}, (f32x2){bflo(x1.w), bfhi(x1.w)}};
#pragma unroll
                  for (int p = 0; p < 8; ++p) { y[p] = xr[p] * ALPHA + (f32x2){(float)yh[s][p].x, (float)yh[s][p].y} * (1.f / (PV_SCALE * Y_AK)); sm += y[p].x + y[p].y; } }
                const float mean = wave_sum(sm) * (1.f / D);
                float s2 = 0.f;
#pragma unroll
                for (int p = 0; p < 8; ++p) { y[p] = y[p] - mean; s2 += y[p].x * y[p].x + y[p].y * y[p].y; }
                const float rstd = __builtin_amdgcn_rsqf(wave_sum(s2) * (1.f / D) + LN_EPS);
                if (dry) asm volatile("" :: "v"(rstd));
                if (s < nvv && !dry) {
                    const size_t ro = (size_t)t * D + lane * 16;
                    unsigned wb[8];
#pragma unroll
                    for (int c = 0; c < 4; ++c) {
                        const f32x4 ga = g2q[c], ba = b2q[c];
                        f32x4 o;
                        o[0] = y[2 * c].x * rstd * ga[0] + ba[0]; o[1] = y[2 * c].y * rstd * ga[1] + ba[1];
                        o[2] = y[2 * c + 1].x * rstd * ga[2] + ba[2]; o[3] = y[2 * c + 1].y * rstd * ga[3] + ba[3];
                        wb[2 * c] = pk2(o[0], o[1]); wb[2 * c + 1] = pk2(o[2], o[3]);
                    }
                    *(v4u*)(hb + ro) = (v4u){wb[0], wb[1], wb[2], wb[3]}; *(v4u*)(hb + ro + 8) = (v4u){wb[4], wb[5], wb[6], wb[7]};
                }
            }
        }
#undef G_STEPV
#undef G_CVH
#undef G_FILL
#undef G_SYNC
    }
}

__device__ __forceinline__ void phase_attn(Frame& F, int jl  ) {
    unsigned char* ws = F.ws;
    const bf16* qb = (const bf16*)(ws + WS_QB); const bf16* kvb = (const bf16*)(ws + WS_KVB); bf16* att = (bf16*)(ws + WS_ATT);
    const float* sinks = inp(IN_SINK) + jl * 16;
    constexpr int KS = 144, VSB = 192;
    LAS unsigned char* Kl = F.lds; LAS unsigned char* Vl = F.lds + 256 * KS;
    const int lane = F.lane, ql = lane & 31, hh2 = lane >> 5;
    for (int unit = F.bx; unit < 256; unit += F.G) {
        const int b = unit >> 7, n = (unit >> 1) & 63, kvh = unit & 1;
        const int tokb = b * 8192 + 128 * n;
#pragma unroll
        for (int i = 0; i < 4; ++i) {
            const int id = F.tid + 512 * i, row = id >> 3, ch = id & 7;
            const int tok = (row < 128) ? ((n > 0) ? tokb - 128 + row : tokb + row) : tokb + row - 128;
            const v4u kk = *(const v4u*)(kvb + (size_t)tok * 256 + kvh * 64 + ch * 8);
            const v4u vv = *(const v4u*)(kvb + (size_t)tok * 256 + 128 + kvh * 64 + ch * 8);
            *(LAS v4u*)(Kl + row * KS + ch * 16) = kk; *(LAS v4u*)(Vl + row * VSB + ch * 16) = vv;
        }
        __syncthreads();
        const int hd = kvh * 8 + F.wave;
        const float slope = fexp2(-0.5f * (float)(hd + 1)), sink = sinks[hd];
        const unsigned vlane = (unsigned)(uintptr_t)Vl + (unsigned)((4 * (lane >> 5) + ((lane & 15) >> 2)) * VSB + (16 * ((lane >> 4) & 1) + 4 * (lane & 3)) * 2);
        const GAS bf16* qg = (const GAS bf16*)qb; GAS bf16* ag = (GAS bf16*)att;
        bf16x8 qf[4];
#pragma unroll
        for (int s = 0; s < 4; ++s) qf[s] = *(const GAS bf16x8*)(qg + (size_t)(tokb + ql) * D + hd * 64 + 16 * s + 8 * hh2);
#pragma unroll 1
        for (int qs = 0; qs < 4; ++qs) {
            const int tq = tokb + 32 * qs + ql;
            bf16x8 qn[4];
            { const int tqn = tokb + 32 * (qs < 3 ? qs + 1 : qs) + ql;
#pragma unroll
              for (int s = 0; s < 4; ++s) qn[s] = *(const GAS bf16x8*)(qg + (size_t)tqn * D + hd * 64 + 16 * s + 8 * hh2); }
            f32x16 st[5];
#pragma unroll
            for (int t5 = 0; t5 < 5; ++t5) {
                f32x16 acc;
#pragma unroll
                for (int r = 0; r < 16; ++r) acc[r] = 0.f;
                const int kt = qs + t5;
#pragma unroll
                for (int s = 0; s < 4; ++s) {
                    const bf16x8 kf = *(const LAS bf16x8*)(Kl + (32 * kt + ql) * KS + (16 * s + 8 * hh2) * 2);
                    acc = __builtin_amdgcn_mfma_f32_32x32x16_bf16(kf, qf[s], acc, 0, 0, 0);
                }
                st[t5] = acc;
            }
            const int iq = 32 * qs + ql;
            float m = sink;
#pragma unroll
            for (int t5 = 0; t5 < 5; ++t5)
#pragma unroll
                for (int r = 0; r < 16; ++r) {
                    const int j = 32 * (qs + t5) + (r & 3) + 8 * (r >> 2) + 4 * hh2;
                    const int dist = iq + 128 - j;
                    const bool valid = (dist >= 0) && (dist < 128) && ((n > 0) || (j >= 128));
                    const float sv = valid ? st[t5][r] * 0.125f - slope * (float)dist : -INFINITY;
                    st[t5][r] = sv; m = fmaxf(m, sv);
                }
            m = fmaxf(m, bperm(lane ^ 32, m));
            float l = 0.f;
            v4u pw[5][2];
#pragma unroll
            for (int t5 = 0; t5 < 5; ++t5)
#pragma unroll
                for (int s2 = 0; s2 < 2; ++s2) {
                    float p[8];
#pragma unroll
                    for (int e = 0; e < 8; ++e) { p[e] = fexp2((st[t5][8 * s2 + e] - m) * 1.4426950408889634f); l += p[e]; }
                    pw[t5][s2] = (v4u){pk2(p[0], p[1]), pk2(p[2], p[3]), pk2(p[4], p[5]), pk2(p[6], p[7])};
                }
            l += bperm(lane ^ 32, l);
            l += fexp2((sink - m) * 1.4426950408889634f);
#if defined(DBG_NOATT)
            const float inv = 0.f / l;
#else
            const float inv = 1.0f / l;
#endif
            f32x16 o0, o1;
#pragma unroll
            for (int r = 0; r < 16; ++r) { o0[r] = 0.f; o1[r] = 0.f; }
#pragma unroll
            for (int t5 = 0; t5 < 5; ++t5) {
                const int kt = qs + t5;
#pragma unroll
                for (int s2 = 0; s2 < 2; ++s2) {
                    const bf16x8 pf = __builtin_bit_cast(bf16x8, pw[t5][s2]);
                    s16x4 a0, a1, c0, c1;
                    const unsigned va = vlane + (unsigned)((32 * kt + 16 * s2) * VSB);
                    asm volatile("ds_read_b64_tr_b16 %0, %4\n\tds_read_b64_tr_b16 %1, %4 offset:1536\n\tds_read_b64_tr_b16 %2, %4 offset:64\n\tds_read_b64_tr_b16 %3, %4 offset:1600\n\ts_waitcnt lgkmcnt(0)"
                                 : "=&v"(a0), "=&v"(a1), "=&v"(c0), "=&v"(c1) : "v"(va) : "memory");
                    const bf16x8 vf0 = (bf16x8){a0[0], a0[1], a0[2], a0[3], a1[0], a1[1], a1[2], a1[3]};
                    const bf16x8 vf1 = (bf16x8){c0[0], c0[1], c0[2], c0[3], c1[0], c1[1], c1[2], c1[3]};
                    o0 = __builtin_amdgcn_mfma_f32_32x32x16_bf16(vf0, pf, o0, 0, 0, 0);
                    o1 = __builtin_amdgcn_mfma_f32_32x32x16_bf16(vf1, pf, o1, 0, 0, 0);
                }
            }
            GAS bf16* op = ag + (size_t)tq * D + hd * 64 + 4 * hh2;
#pragma unroll
            for (int g4 = 0; g4 < 4; ++g4) {
                v2u w; w.x = pk2(o0[4 * g4 + 0] * inv, o0[4 * g4 + 1] * inv); w.y = pk2(o0[4 * g4 + 2] * inv, o0[4 * g4 + 3] * inv);
                *(GAS v2u*)(op + 8 * g4) = w;
                v2u x; x.x = pk2(o1[4 * g4 + 0] * inv, o1[4 * g4 + 1] * inv); x.y = pk2(o1[4 * g4 + 2] * inv, o1[4 * g4 + 3] * inv);
                *(GAS v2u*)(op + 32 + 8 * g4) = x;
            }
#pragma unroll
            for (int s = 0; s < 4; ++s) qf[s] = qn[s];
        }
        __syncthreads();
    }
    {
        const float* ck = inp(IN_CK); const float* cv = inp(IN_CV);
        constexpr int KSS = 68;
        LAS float* Ksm = (LAS float*)F.lds; LAS float* Vsm = (LAS float*)(F.lds + 136 * KSS * 4);
        for (int su = F.bx; su < 256; su += F.G) {
            const int db = su >> 1, kvh = su & 1;
            int tid_ = F.tid; asm volatile("" : "+v"(tid_));
            const int hd = kvh * 8 + F.wave;
            const float slope = fexp2(-0.5f * (float)(hd + 1)), sink = sinks[hd];
            LAS unsigned char* Ql = F.lds + 73728 + F.wave * 1024;
            const v4u qrow = *(const v4u*)(qb + (size_t)(TP + db * 8 + (lane >> 3)) * D + hd * 64 + (lane & 7) * 8);
            {
                f32x4 kq[4], vq[4]; v2u kw = {0u, 0u}, vw = {0u, 0u};
#pragma unroll
                for (int i = 0; i < 4; ++i) { const int id = tid_ + 512 * i, j = id >> 4, c4 = (id & 15) * 4;
                    kq[i] = *(const f32x4*)(ck + ((size_t)(db * 128 + j) * 2 + kvh) * 64 + c4); vq[i] = *(const f32x4*)(cv + ((size_t)(db * 128 + j) * 2 + kvh) * 64 + c4); }
                if (tid_ < 128) { const int j = 128 + (tid_ >> 4), c4 = (tid_ & 15) * 4;
                    kw = *(const v2u*)(kvb + (size_t)(TP + db * 8 + j - 128) * 256 + kvh * 64 + c4); vw = *(const v2u*)(kvb + (size_t)(TP + db * 8 + j - 128) * 256 + 128 + kvh * 64 + c4); }
#pragma unroll
                for (int i = 0; i < 4; ++i) { const int id = tid_ + 512 * i, j = id >> 4, c4 = (id & 15) * 4;
                    *(LAS f32x4*)(Ksm + j * KSS + c4) = kq[i]; *(LAS f32x4*)(Vsm + j * 64 + c4) = vq[i]; }
                if (tid_ < 128) { const int j = 128 + (tid_ >> 4), c4 = (tid_ & 15) * 4;
                    *(LAS f32x4*)(Ksm + j * KSS + c4) = (f32x4){bflo(kw.x), bfhi(kw.x), bflo(kw.y), bfhi(kw.y)}; *(LAS f32x4*)(Vsm + j * 64 + c4) = (f32x4){bflo(vw.x), bfhi(vw.x), bflo(vw.y), bfhi(vw.y)}; }
                *(LAS v4u*)(Ql + lane * 16) = qrow;
            }
            __syncthreads();
#pragma unroll 2
            for (int l = 0; l < 8; ++l) {
                const int tq = TP + db * 8 + l;
                v4u qv[8];
#pragma unroll
                for (int i = 0; i < 8; ++i) qv[i] = *(const LAS v4u*)(Ql + l * 128 + i * 16);
                float sc[3];
#pragma unroll
                for (int ps = 0; ps < 3; ++ps) {
                    const int jj = lane + 64 * ps, jr = jj < 136 ? jj : 135;
                    const LAS float* kr = Ksm + jr * KSS;
                    float dot = 0.f;
#pragma unroll
                    for (int i = 0; i < 8; ++i) {
                        const f32x4 k0 = *(const LAS f32x4*)(kr + i * 8), k1 = *(const LAS f32x4*)(kr + i * 8 + 4);
                        dot += bflo(qv[i].x) * k0[0] + bfhi(qv[i].x) * k0[1] + bflo(qv[i].y) * k0[2] + bfhi(qv[i].y) * k0[3]
                             + bflo(qv[i].z) * k1[0] + bfhi(qv[i].z) * k1[1] + bflo(qv[i].w) * k1[2] + bfhi(qv[i].w) * k1[3];
                    }
                    const int dist = l + 128 - jj;
                    const bool valid = (jj < 136) && (dist >= 0) && (dist < 128);
                    sc[ps] = valid ? dot * 0.125f - slope * (float)dist : -INFINITY;
                }
                const float m = fmaxf(wave_max(fmaxf(fmaxf(sc[0], sc[1]), sc[2])), sink);
                const float p0 = fexp2((sc[0] - m) * 1.4426950408889634f), p1 = fexp2((sc[1] - m) * 1.4426950408889634f), p2 = fexp2((sc[2] - m) * 1.4426950408889634f);
                const float lsum = wave_sum(p0 + p1 + p2) + fexp2((sink - m) * 1.4426950408889634f);
                float oa[4] = {0.f, 0.f, 0.f, 0.f};
                const int p0i = __builtin_bit_cast(int, p0), p1i = __builtin_bit_cast(int, p1), p2i = __builtin_bit_cast(int, p2);
#pragma unroll 4
                for (int jb = 0; jb < 64; jb += 4) {
#pragma unroll
                    for (int u = 0; u < 4; ++u) {
                        oa[u] += __builtin_bit_cast(float, __builtin_amdgcn_readlane(p0i, jb + u)) * Vsm[(jb + u) * 64 + lane];
                        oa[u] += __builtin_bit_cast(float, __builtin_amdgcn_readlane(p1i, jb + u)) * Vsm[(jb + u + 64) * 64 + lane];
                    }
                }
#pragma unroll
                for (int jj = 0; jj < 8; ++jj) oa[jj & 3] += __builtin_bit_cast(float, __builtin_amdgcn_readlane(p2i, jj)) * Vsm[(128 + jj) * 64 + lane];
                const float o = (oa[0] + oa[1]) + (oa[2] + oa[3]);
#if defined(DBG_NOATT)
                att[(size_t)tq * D + hd * 64 + lane] = (bf16)f2bf(0.f * o / lsum);
#else
                att[(size_t)tq * D + hd * 64 + lane] = (bf16)f2bf(o / lsum);
#endif
            }
            __syncthreads();
        }
    }
}

#ifndef PH_MASK
#define PH_MASK 0xFFFF
#endif
#define PHM(b) ((PH_MASK >> (b)) & 1)
#ifndef DBG_REP
#define DBG_REP 0
#endif

struct Args { const float* in[29]; float* out; unsigned char* ws; int ph_lo, ph_hi; };
__global__ void __launch_bounds__(NWAVES * 64, 2) yoco_fwd(Args args) {
    extern __shared__ __attribute__((aligned(16))) unsigned char lds_raw[];
    Frame F;
    F.lds = (LAS unsigned char*)lds_raw;
    F.MISC = (volatile LAS unsigned*)(F.lds + MISC_OFF);
    const int wave0 = __builtin_amdgcn_readfirstlane(threadIdx.x >> 6);
    F.tid = threadIdx.x; F.lane = F.tid & 63; F.wave = wave0;
    F.G = gridDim.x;
    F.out = args.out; F.ws = args.ws; F.ctl = (gu32*)(args.ws + WS_CTL);
    GAS unsigned char* wsg = (GAS unsigned char*)args.ws;
    unsigned char* ws = args.ws;
    for (int u = F.tid; u < (LDS_BYTES - LDSCTL_OFF) / 4; u += NWAVES * 64) ((LAS unsigned*)(F.lds + LDSCTL_OFF))[u] = 0u;
    __syncthreads();
    XcdBarrier bar; bar.bar = (unsigned*)(F.ctl + CW_BAR); bar.x = 0; bar.st = nullptr;
    if (MK_N_LAUNCHES == 1) bar = xcd_barrier_post((unsigned*)(F.ctl + CW_BAR), F.MISC + 8);

    for (int it = 2 * args.ph_lo; it < 2 * args.ph_hi; ++it) {
        const int ph = it >> 1;
        int cls = (ph < 2) ? ph + 8 : ((ph - 2) & 7);
        if (cls == 1 && ph >= 18) cls = 10;
        const bool twice = ((DBG_REP >> cls) & 1) != 0;
        if (!(it & 1) && !twice) continue;
        const bool dry = !(it & 1);
#define FRESH() do { int l_; asm volatile("v_mbcnt_lo_u32_b32 %0, -1, 0\n\tv_mbcnt_hi_u32_b32 %0, -1, %0" : "=v"(l_)); F.lane = l_; F.wave = wave0; F.tid = wave0 * 64 + l_; } while (0)
        unsigned char* wsf = args.ws; asm volatile("" : "+s"(wsf));
        asm volatile("" : "+s"(wsg)); ws = (unsigned char*)wsg; F.ws = ws;
        int bx = blockIdx.x, gx = gridDim.x; asm volatile("" : "+s"(bx), "+s"(gx)); F.G = gx; F.bx = bx;
        if (ph == 0) {
            FRESH(); if (PHM(0)) phase_prologue(F);
        } else if (ph == 1) {
            FRESH();
            if (PHM(2)) {
                pg8::Gemm g2{(const bf16*)(ws + WS_PBF), (const bf16*)(ws + WS_PLE), 4 * T, 1024, 256};
                pg8::StaticOrder S2; S2.init(4 * T, 1024, F.G, (bx + 192) % F.G, T / 256);
                EpiBf E2{(bf16*)(ws + WS_PP), 1024};
                pg8::gemm_phase<EpiBf, pg8::StaticOrder, true, true>(F.lds, g2, S2, E2, F.tid);
            }
        } else {
            const int qq = ph - 2, layer = qq >> 3, sub = qq & 7;
            bf16* HBc = (bf16*)(ws + ((layer & 1) ? WS_HB2 : WS_HB));
            bf16* HBn = (bf16*)(ws + ((layer & 1) ? WS_HB : WS_HB2));
            if (sub == 0) {
                FRESH();
                if (!PHM(1)) {} else if (layer < 2) {
                    pg8::Gemm g{HBc, (const bf16*)(ws + WS_WIN) + (size_t)layer * 4096 * 1024, T, 4096, 1024};
                    pg8::StaticOrder S; S.init(T, 4096, F.G, bx);
                    EpiZ E{(bf16*)(ws + WS_Z), inp(IN_BIN) + layer * 4096, (float*)(ws + WS_STATS)};
                    pg8::gemm_phase<EpiZ, pg8::StaticOrder, true, true>(F.lds, g, S, E, F.tid);
                    FRESH(); table_filler(F, layer, 0, (T / 256) * 16);
                } else if (PHM(3)) {
                    const bool first = (layer == 2);
                    pg8::Gemm g{HBc, (const bf16*)(ws + (first ? WS_WQKV : WS_WQ1)), first ? T : TP, first ? 1280 : 1024, 1024};
                    pg8::StaticOrder S; S.init(first ? T : TP, first ? 1280 : 1024, F.G, bx);
                    EpiQKV E{(bf16*)(ws + WS_QB), (bf16*)(ws + WS_KVB), F.out};
                    pg8::gemm_phase<EpiQKV, pg8::StaticOrder, true, true>(F.lds, g, S, E, F.tid);
                    FRESH();
                    if (!first) sgemm64(F, g.A, g.Bt, TP, TS / 64, 16, g.K, E);
                    if (first) table_filler(F, layer, 0, (T / 256) * 5);
                }
            } else if (sub == 1) {
                FRESH();
                if (layer < 2) { if (PHM(4)) phase_spatial(F, layer); } else { F.ws = wsf; if (PHM(5)) phase_attn(F, layer - 2); }
            } else if (sub == 2 && PHM(6)) {
                FRESH();
                const bool isa = layer < 2;
                pg8::Gemm g{isa ? (const bf16*)(ws + WS_GATED) : (const bf16*)(ws + WS_ATT),
                            isa ? (const bf16*)(ws + WS_WOUT) + (size_t)layer * 1024 * 2048 : (const bf16*)(ws + WS_WO) + (size_t)(layer - 2) * 1024 * 1024, TP, 1024, isa ? 2048 : 1024};
                pg8::StaticOrder S; S.init(TP, 1024, F.G, bx);
                EpiPre E{(bf16*)(ws + WS_PRE), HBc, isa ? inp(IN_BOUT) + layer * 1024 : nullptr};
                pg8::gemm_phase<EpiPre, pg8::StaticOrder, true, true>(F.lds, g, S, E, F.tid);
                FRESH(); sgemm64(F, g.A, g.Bt, TP, TS / 64, 16, g.K, E);
            } else if (sub == 3 && PHM(7)) {
                FRESH();
                phase_ln1(F, layer, HBc);
            } else if (sub == 4 && PHM(8)) {
                FRESH();
                pg8::Gemm g{(const bf16*)(ws + WS_WQK) + (size_t)layer * 2048 * 1024, HBc, 2048, T, 1024};
                pg8::StaticOrder S; S.init(2048, T, F.G, bx);
                EpiF32 E{(unsigned*)(ws + WS_SC), T};
                pg8::gemm_phase<EpiF32, pg8::StaticOrder, true, true>(F.lds, g, S, E, F.tid);
                FRESH(); table_filler(F, layer, 1, 8 * (T / 256));
                if (layer == 3) table_filler(F, layer, 0, 8 * (T / 256));
            } else if (sub == 5 && PHM(9)) {
                FRESH();
                phase_topk(F);
            } else if (sub == 6 && PHM(10)) {
                FRESH();
                phase_gather(F, layer, HBc, dry);
            } else if (sub == 7 && PHM(11)) {
                FRESH();
                pg8::Gemm g{HBc, (const bf16*)(ws + WS_GATE) + (size_t)layer * 1024 * 1024, TP, 1024, 1024};
                pg8::StaticOrder S; S.init(TP, 1024, F.G, bx);
                EpiGate E{HBc, HBn, (const bf16*)(ws + WS_PP) + (size_t)layer * T * 1024, inp(IN_GB) + layer * 1024, layer == 3 ? F.out : nullptr};
                pg8::gemm_phase<EpiGate, pg8::StaticOrder, true, true>(F.lds, g, S, E, F.tid);
                FRESH(); sgemm64(F, g.A, g.Bt, TP, TS / 64, 16, g.K, E);
            }
        }
        const bool same_wg_seam = (MK_N_LAUNCHES == 1) && (ph >= 2) && (((ph - 2) & 7) == 5);
        if (ph == 1 && MK_N_LAUNCHES == 1) { }
        else if (same_wg_seam) { asm volatile("s_waitcnt vmcnt(0)" ::: "memory"); __syncthreads(); }
        else if (it + 1 < 2 * args.ph_hi) { int l_; asm volatile("v_mbcnt_lo_u32_b32 %0, -1, 0\n\tv_mbcnt_hi_u32_b32 %0, -1, %0" : "=v"(l_)); xcd_barrier(bar, wave0 * 64 + l_); if ((DBG_REP >> 11) & 1) xcd_barrier(bar, wave0 * 64 + l_); }
    }
}

extern "C" void kernel_launch(void* const* d_in, const int* in_sizes, int n_in, void* d_out, int out_size, void* d_ws, size_t ws_size, hipStream_t stream) {
    static int grid = 0;
    if (grid == 0) {
        if (n_in != 29 || (size_t)out_size != O_END || ws_size < WS_END) {
            fprintf(stderr, "kernel_launch: built for 29 inputs, %zu outputs, >= %zu bytes of workspace; got n_in %d, out %d, ws %zu; nothing launched\n", (size_t)O_END, (size_t)WS_END, n_in, out_size, ws_size);
            grid = -1; return;
        }
        int dev = 0, cus = 0;
        if (hipGetDevice(&dev) != hipSuccess || hipDeviceGetAttribute(&cus, hipDeviceAttributeMultiprocessorCount, dev) != hipSuccess) { grid = -1; return; }
        if (hipFuncSetAttribute((const void*)yoco_fwd, hipFuncAttributeMaxDynamicSharedMemorySize, LDS_BYTES) != hipSuccess) { fprintf(stderr, "kernel_launch: hipFuncSetAttribute failed\n"); grid = -1; return; }
        (void)hipGetLastError();
        grid = cus;
    }
    if (grid < 0) return;
    if (hipMemsetAsync((char*)d_ws + WS_CTL, 0, CTL_ZERO_BYTES, stream) != hipSuccess) { fprintf(stderr, "kernel_launch: hipMemsetAsync failed\n"); return; }
    Args a{};
    for (int i = 0; i < 29; ++i) a.in[i] = (const float*)d_in[i];
    a.out = (float*)d_out; a.ws = (unsigned char*)d_ws;
#if MK_N_LAUNCHES == 1
    a.ph_lo = 0; a.ph_hi = NPHASE;
    hipLaunchKernelGGL(yoco_fwd, dim3(grid), dim3(NWAVES * 64), LDS_BYTES, stream, a);
#else
    for (int ph = 0; ph < NPHASE; ++ph) { a.ph_lo = ph; a.ph_hi = ph + 1; hipLaunchKernelGGL(yoco_fwd, dim3(grid), dim3(NWAVES * 64), LDS_BYTES, stream, a); }
#endif
    const hipError_t le = hipPeekAtLastError();
    if (le != hipSuccess) fprintf(stderr, "kernel_launch: launch failed: %s (grid %d)\n", hipGetErrorName(le), grid);
}
```
